# Optimizing an MI355X kernel written in HIP

```python
import math
import jax, jax.numpy as jnp
from jax import lax
import numpy as np

D_MODEL = 2048
BATCH = 2
SEQ = 8192
DEPTH = 1

FOX_HEADS = 8
FOX_HEAD_DIM = 128
Q_BLOCK = 128
GDN_HEADS = 8
GDN_HEAD_DIM = 128
CONV_WIDTH = 4
GDN_CHUNK = 64
N_EXPERTS = 32
TOP_K = 4
D_FF = D_MODEL
SWIGLU_LIMIT = 7.0
SWIGLU_ALPHA = 1.702
MOE_BLOCK = 128
RMS_EPS = 1e-6

FOX_W = FOX_HEADS * FOX_HEAD_DIM
GDN_W = GDN_HEADS * GDN_HEAD_DIM
SPLITS = (FOX_W, FOX_W, FOX_W, FOX_HEADS, 3 * GDN_W, GDN_W, GDN_HEADS, GDN_HEADS, D_MODEL, D_MODEL)
IN_COLS = 3 * FOX_W + FOX_HEADS + 4 * GDN_W + 2 * GDN_HEADS + 2 * D_MODEL

kernel_name = "fox_gdn_gated_hybrid_moe_layer"


def rms_norm(x, w):
    xf = x.astype(jnp.float32)
    y = xf * lax.rsqrt(jnp.mean(xf * xf, axis=-1, keepdims=True) + RMS_EPS)
    return (y * w.astype(jnp.float32)).astype(x.dtype)


def l2_normalize(x):
    return x * lax.rsqrt(jnp.sum(x * x, axis=-1, keepdims=True) + RMS_EPS)


def fox_attention(q, k, v, f_logit, q_norm_w, k_norm_w):
    B, S, H, Dh = q.shape
    qf = rms_norm(q, q_norm_w).astype(jnp.float32) * (Dh ** -0.5)
    kf = rms_norm(k, k_norm_w).astype(jnp.float32)
    vf = v.astype(jnp.float32)
    c = jnp.cumsum(jax.nn.log_sigmoid(f_logit.astype(jnp.float32)), axis=1)
    c_k = jnp.transpose(c, (0, 2, 1))
    nblk = S // Q_BLOCK
    qb = jnp.moveaxis(qf.reshape(B, nblk, Q_BLOCK, H, Dh), 1, 0)
    cb = jnp.moveaxis(c.reshape(B, nblk, Q_BLOCK, H), 1, 0)
    k_pos = jnp.arange(S)

    def one_block(args):
        i, q_i, c_i = args
        s = jnp.einsum('bqhd,bkhd->bhqk', q_i, kf)
        s = s + jnp.transpose(c_i, (0, 2, 1))[..., :, None] - c_k[..., None, :]
        q_pos = i * Q_BLOCK + jnp.arange(Q_BLOCK)
        causal = q_pos[:, None] >= k_pos[None, :]
        s = jnp.where(causal, s, -jnp.inf)
        p = jax.nn.softmax(s, axis=-1)
        return jnp.einsum('bhqk,bkhd->bqhd', p, vf)

    o = lax.map(one_block, (jnp.arange(nblk), qb, cb))
    return jnp.moveaxis(o, 0, 1).reshape(B, S, H * Dh).astype(v.dtype)


def causal_depthwise_conv(x, w):
    K, C = w.shape
    return lax.conv_general_dilated(
        x, w[:, None, :].astype(x.dtype), window_strides=(1,), padding=[(K - 1, 0)],
        dimension_numbers=('NWC', 'WIO', 'NWC'), feature_group_count=C)


def gated_delta_rule_chunked(q, k, v, g, beta):
    B, S, H, Dk = q.shape
    Dv = v.shape[-1]
    C = GDN_CHUNK
    N = S // C

    def to_chunks(t):
        return jnp.moveaxis(t.reshape((B, N, C, H) + t.shape[3:]), 3, 1)

    qc = to_chunks(q) * (Dk ** -0.5)
    kc = to_chunks(k)
    vc = to_chunks(v)
    bc = to_chunks(beta)
    gc = jnp.cumsum(to_chunks(g), axis=-1)
    idx = jnp.arange(C)
    incl = idx[:, None] >= idx[None, :]
    strict = idx[:, None] > idx[None, :]
    decay = jnp.exp(jnp.where(incl, gc[..., :, None] - gc[..., None, :], -jnp.inf))
    k_beta = kc * bc[..., None]
    v_beta = vc * bc[..., None]
    L = jnp.where(strict, jnp.einsum('bhnid,bhnjd->bhnij', k_beta, kc) * decay, 0.0)
    A = L + jnp.eye(C, dtype=L.dtype)
    rhs = jnp.concatenate([v_beta, k_beta * jnp.exp(gc)[..., None]], axis=-1)
    sol = lax.linalg.triangular_solve(A, rhs, left_side=True, lower=True, unit_diagonal=True)
    u, w = sol[..., :Dv], sol[..., Dv:]
    attn = jnp.einsum('bhnid,bhnjd->bhnij', qc, kc) * decay
    q_dec = qc * jnp.exp(gc)[..., None]
    k_dec = kc * jnp.exp(gc[..., -1:] - gc)[..., None]
    g_last = jnp.exp(gc[..., -1])
    xs = (jnp.moveaxis(u, 2, 0), jnp.moveaxis(w, 2, 0), jnp.moveaxis(attn, 2, 0),
          jnp.moveaxis(q_dec, 2, 0), jnp.moveaxis(k_dec, 2, 0), jnp.moveaxis(g_last, 2, 0))

    def step(state, inp):
        u_n, w_n, attn_n, q_n, k_n, gl_n = inp
        v_new = u_n - jnp.einsum('bhck,bhkv->bhcv', w_n, state)
        o_n = jnp.einsum('bhck,bhkv->bhcv', q_n, state) + jnp.einsum('bhij,bhjv->bhiv', attn_n, v_new)
        state = state * gl_n[..., None, None] + jnp.einsum('bhck,bhcv->bhkv', k_n, v_new)
        return state, o_n

    state0 = jnp.zeros((B, H, Dk, Dv), jnp.float32)
    _, o = lax.scan(step, state0, xs)
    o = jnp.moveaxis(jnp.moveaxis(o, 0, 2), 1, 3)
    return o.reshape(B, S, H, Dv)


def gdn_branch(qkv_raw, z, beta_logit, alpha_logit, conv_w, A_log, dt_bias, out_norm_w):
    B, S, _ = qkv_raw.shape
    H, Dh = GDN_HEADS, GDN_HEAD_DIM
    qkv = jax.nn.silu(causal_depthwise_conv(qkv_raw, conv_w)).astype(jnp.float32)
    q, k, v = jnp.split(qkv, 3, axis=-1)
    q = l2_normalize(q.reshape(B, S, H, Dh))
    k = l2_normalize(k.reshape(B, S, H, Dh))
    v = v.reshape(B, S, H, Dh)
    beta = jax.nn.sigmoid(beta_logit.astype(jnp.float32))
    g = -jnp.exp(A_log.astype(jnp.float32)) * jax.nn.softplus(alpha_logit.astype(jnp.float32) + dt_bias.astype(jnp.float32))
    o = gated_delta_rule_chunked(q, k, v, g, beta)
    o = rms_norm(o, out_norm_w) * jax.nn.silu(z.reshape(B, S, H, Dh).astype(jnp.float32))
    return o.reshape(B, S, H * Dh).astype(qkv_raw.dtype)


def moe_ffn(x, w_router, b_router, w_gate_up, b_gate_up, w_down, b_down):
    B, S, D = x.shape
    T = B * S
    xt = x.reshape(T, D)
    logits = (xt @ w_router + b_router).astype(jnp.float32)
    top_val, top_idx = lax.top_k(logits, TOP_K)
    top_w = jax.nn.softmax(top_val, axis=-1).astype(x.dtype)
    A = T * TOP_K
    e_flat = top_idx.reshape(A).astype(jnp.int32)
    tok_flat = jnp.arange(A, dtype=jnp.int32) // TOP_K
    w_flat = top_w.reshape(A)
    order = jnp.argsort(e_flat)
    e_sorted = e_flat[order]
    counts = jnp.bincount(e_flat, length=N_EXPERTS).astype(jnp.int32)
    starts = jnp.cumsum(counts) - counts
    padded = (counts + MOE_BLOCK - 1) // MOE_BLOCK * MOE_BLOCK
    pad_end = jnp.cumsum(padded)
    pad_start = pad_end - padded
    rank = jnp.arange(A, dtype=jnp.int32) - starts[e_sorted]
    dest = pad_start[e_sorted] + rank
    n_blocks = -(-A // MOE_BLOCK) + N_EXPERTS
    P = n_blocks * MOE_BLOCK
    slot_tok = jnp.full((P,), T, jnp.int32).at[dest].set(tok_flat[order])
    slot_w = jnp.zeros((P,), x.dtype).at[dest].set(w_flat[order])
    block_expert = jnp.minimum(
        jnp.searchsorted(pad_end, jnp.arange(n_blocks, dtype=jnp.int32) * MOE_BLOCK, side='right'),
        N_EXPERTS - 1).astype(jnp.int32)
    x_pad = jnp.concatenate([xt, jnp.zeros((1, D), xt.dtype)], axis=0)

    def expert_block(args):
        e, tok = args
        h = x_pad[tok] @ w_gate_up[e] + b_gate_up[e]
        gate = jnp.minimum(h[:, 0::2], SWIGLU_LIMIT)
        lin = jnp.clip(h[:, 1::2], -SWIGLU_LIMIT, SWIGLU_LIMIT)
        act = gate * jax.nn.sigmoid(SWIGLU_ALPHA * gate) * (lin + 1.0)
        return act @ w_down[e] + b_down[e]

    y = lax.map(expert_block, (block_expert, slot_tok.reshape(n_blocks, MOE_BLOCK)))
    y = y.reshape(P, D) * slot_w[:, None]
    out = jax.ops.segment_sum(y, slot_tok, num_segments=T + 1)[:T]
    return out.reshape(B, S, D).astype(x.dtype)


def setup_inputs(seed: int = 0) -> dict:
    key = jax.random.key(seed)
    ks = jax.random.split(key, 24)
    f32 = jnp.float32
    L = DEPTH

    def nrm(k, shape, scale):
        return jax.random.normal(k, shape, f32) * scale

    x = jax.random.normal(ks[0], (BATCH, SEQ, D_MODEL), f32)
    norm1_w = 1.0 + nrm(ks[1], (L, D_MODEL), 0.02)
    w_in = nrm(ks[2], (L, D_MODEL, IN_COLS), D_MODEL ** -0.5)
    b_fox_f = jnp.linspace(2.0, 6.0, FOX_HEADS, dtype=f32)[None, :] + nrm(ks[3], (L, FOX_HEADS), 0.1)
    fox_q_norm_w = 1.0 + nrm(ks[4], (L, FOX_HEAD_DIM), 0.02)
    fox_k_norm_w = 1.0 + nrm(ks[5], (L, FOX_HEAD_DIM), 0.02)
    gdn_conv_w = nrm(ks[6], (L, CONV_WIDTH, 3 * GDN_W), CONV_WIDTH ** -0.5)
    gdn_A_log = jnp.log(jax.random.uniform(ks[7], (L, GDN_HEADS), f32, 1.0, 16.0))
    dt = jnp.exp(jax.random.uniform(ks[8], (L, GDN_HEADS), f32, math.log(1e-3), math.log(1e-1)))
    gdn_dt_bias = dt + jnp.log(-jnp.expm1(-dt))
    gdn_out_norm_w = 1.0 + nrm(ks[9], (L, GDN_HEAD_DIM), 0.02)
    w_up_fox = nrm(ks[10], (L, FOX_W, D_MODEL), FOX_W ** -0.5)
    w_up_gdn = nrm(ks[11], (L, GDN_W, D_MODEL), GDN_W ** -0.5)
    w_o = nrm(ks[12], (L, D_MODEL, D_MODEL), D_MODEL ** -0.5)
    norm2_w = 1.0 + nrm(ks[13], (L, D_MODEL), 0.02)
    w_router = nrm(ks[14], (L, D_MODEL, N_EXPERTS), D_MODEL ** -0.5)
    b_router = nrm(ks[15], (L, N_EXPERTS), 0.01)
    w_gate_up = nrm(ks[16], (L, N_EXPERTS, D_MODEL, 2 * D_FF), D_MODEL ** -0.5)
    b_gate_up = nrm(ks[17], (L, N_EXPERTS, 2 * D_FF), 0.01)
    w_down = nrm(ks[18], (L, N_EXPERTS, D_FF, D_MODEL), D_FF ** -0.5)
    b_down = nrm(ks[19], (L, N_EXPERTS, D_MODEL), 0.01)
    return {"x": x, "norm1_w": norm1_w, "w_in": w_in, "b_fox_f": b_fox_f,
            "fox_q_norm_w": fox_q_norm_w, "fox_k_norm_w": fox_k_norm_w,
            "gdn_conv_w": gdn_conv_w, "gdn_A_log": gdn_A_log, "gdn_dt_bias": gdn_dt_bias,
            "gdn_out_norm_w": gdn_out_norm_w, "w_up_fox": w_up_fox, "w_up_gdn": w_up_gdn,
            "w_o": w_o, "norm2_w": norm2_w, "w_router": w_router, "b_router": b_router,
            "w_gate_up": w_gate_up, "b_gate_up": b_gate_up, "w_down": w_down, "b_down": b_down}


def reference(x, norm1_w, w_in, b_fox_f, fox_q_norm_w, fox_k_norm_w, gdn_conv_w, gdn_A_log,
              gdn_dt_bias, gdn_out_norm_w, w_up_fox, w_up_gdn, w_o, norm2_w, w_router, b_router,
              w_gate_up, b_gate_up, w_down, b_down):
    B, S, _ = x.shape
    split_at = [int(i) for i in np.cumsum(SPLITS)[:-1]]
    for l in range(DEPTH):
        h = rms_norm(x, norm1_w[l])
        proj = h @ w_in[l]
        fq, fk, fv, ff, gqkv, gz, gb, ga, gate_a, gate_b = jnp.split(proj, split_at, axis=-1)
        y_fox = fox_attention(
            fq.reshape(B, S, FOX_HEADS, FOX_HEAD_DIM), fk.reshape(B, S, FOX_HEADS, FOX_HEAD_DIM),
            fv.reshape(B, S, FOX_HEADS, FOX_HEAD_DIM), ff + b_fox_f[l],
            fox_q_norm_w[l], fox_k_norm_w[l])
        y_gdn = gdn_branch(gqkv, gz, gb, ga, gdn_conv_w[l], gdn_A_log[l], gdn_dt_bias[l],
                           gdn_out_norm_w[l])
        merged = (jax.nn.sigmoid(gate_a) * (y_fox @ w_up_fox[l])
                  + jax.nn.sigmoid(gate_b) * (y_gdn @ w_up_gdn[l]))
        x = x + merged @ w_o[l]
        x = x + moe_ffn(rms_norm(x, norm2_w[l]), w_router[l], b_router[l], w_gate_up[l],
                        b_gate_up[l], w_down[l], b_down[l])
    return x
```

```cpp
#define MK_RANGES 0, 13
#define HAVE_GDN 1
#define HAVE_MOE 1
#define MOE_F8_GU 1
#define MOE_F8_DN 1
#define CONV_IN_P4 1
#define CONV_SHARE 3
#define GATES_F8 1
#define YB_F8 1
#define CONV_WGS_P4 96
#define X1_BF16 0
#define MOE_GATHER 1
#define GATES_SIG 1
#include <hip/hip_runtime.h>
#include <cstdio>
#include <cstdint>

#define GAS __attribute__((address_space(1)))
#define LAS __attribute__((address_space(3)))
typedef unsigned short bf16;
typedef short bf16x8 __attribute__((ext_vector_type(8)));
typedef short s16x4 __attribute__((ext_vector_type(4)));
typedef float f32x2 __attribute__((ext_vector_type(2)));
typedef float f32x4 __attribute__((ext_vector_type(4)));
typedef float f32x16 __attribute__((ext_vector_type(16)));
typedef unsigned u32x2 __attribute__((ext_vector_type(2)));
typedef unsigned u32x4 __attribute__((ext_vector_type(4)));
typedef GAS unsigned gu32;
#define RLX_AGENT __ATOMIC_RELAXED, __HIP_MEMORY_SCOPE_AGENT
#define LDS_WAIT() asm volatile("s_waitcnt lgkmcnt(0)" ::: "memory")
#define VM_WAIT() asm volatile("s_waitcnt vmcnt(0)" ::: "memory")

constexpr int BATCH = 2, SEQ = 8192, T = BATCH * SEQ, DM = 2048;
constexpr int NH = 8, HD = 128, FW = NH * HD;
constexpr int NE = 32, TOPK = 4, DFF = 2048;
constexpr int IN_COLS = 11288;
constexpr int NPROJ = 11264;
constexpr int PC_FQ = 0, PC_FK = 1024, PC_FV = 2048, PC_GQKV = 3072, PC_GZ = 6144, PC_GA = 7168, PC_GB = 9216;
constexpr int GCH = 64, NCHUNK = SEQ / GCH, NUNIT = BATCH * NH * NCHUNK;
constexpr int MAXSLOT = 73728;
constexpr float RMS_EPS = 1e-6f;
constexpr int NWAVES = 8;

typedef __bf16 bf16x2_t __attribute__((ext_vector_type(2)));
__device__ __forceinline__ unsigned cvt_pk_bf16(float lo, float hi) { const f32x2 v = {lo, hi}; return __builtin_bit_cast(unsigned, __builtin_convertvector(v, bf16x2_t)); }
__device__ __forceinline__ float bf_lo(unsigned w) { return __builtin_bit_cast(float, w << 16); }
__device__ __forceinline__ float bf_hi(unsigned w) { return __builtin_bit_cast(float, w & 0xffff0000u); }
__device__ __forceinline__ float bf2f(bf16 b) { return __builtin_bit_cast(float, (unsigned)b << 16); }
__device__ __forceinline__ bf16 f2bf(float f) { return (bf16)(cvt_pk_bf16(f, 0.f) & 0xffffu); }
__device__ __forceinline__ float sigmoidf_(float x) { return __builtin_amdgcn_rcpf(1.f + __expf(-x)); }
__device__ __forceinline__ float log1p_small(float e) { return e < 0.0078125f ? e * (1.f - e * (0.5f - e * 0.33333334f)) : __logf(1.f + e); }
__device__ __forceinline__ int crow(int r, int hi) { return (r & 3) + 8 * (r >> 2) + 4 * hi; }
__device__ __forceinline__ float sum16_dpp(float v) {
    v += __builtin_bit_cast(float, __builtin_amdgcn_mov_dpp(__builtin_bit_cast(int, v), 0xB1, 0xF, 0xF, true));
    v += __builtin_bit_cast(float, __builtin_amdgcn_mov_dpp(__builtin_bit_cast(int, v), 0x4E, 0xF, 0xF, true));
    v += __builtin_bit_cast(float, __builtin_amdgcn_mov_dpp(__builtin_bit_cast(int, v), 0x141, 0xF, 0xF, true));
    v += __builtin_bit_cast(float, __builtin_amdgcn_mov_dpp(__builtin_bit_cast(int, v), 0x140, 0xF, 0xF, true));
    return v;
}
__device__ __forceinline__ float wave_sum(float v) {
#pragma unroll
    for (int o = 1; o < 64; o <<= 1) v += __shfl_xor(v, o);
    return v;
}

namespace pg8 {
#define PG8_LAS __attribute__((address_space(3)))
typedef unsigned short bf16_t;
constexpr int BM = 256, BK = 64, HALF = 128, HTB = HALF * BK * 2  , STAGE_BYTES = 8 * HTB, NXCD = 8, WGM = 8;
__host__ __device__ __forceinline__ int lds_byte(int r, int c) { const int st = (r >> 4) * 2 + (c >> 5), rr = r & 15, cc = c & 31, ob = rr * 64 + cc * 2; return st * 1024 + (ob ^ (((ob >> 9) & 1) << 5)); }
__host__ __device__ __forceinline__ void stage_rc(int b, int& R, int& C) { const int st = b / 1024, sb = b % 1024, swz = sb ^ (((sb >> 9) & 1) << 5); R = (st >> 1) * 16 + swz / 64; C = (st & 1) * 32 + (swz % 64) / 2; }
__host__ __device__ __forceinline__ int perm32(int rho) { const int n = rho >> 4, i = rho & 15; return 8 * (i >> 2) + 4 * n + (i & 3); }

struct Unit { int arow, brow, pm, pn, e; };
struct Gemm { const bf16_t* A; const bf16_t* Bt; int K; const PG8_LAS unsigned short* rowtab; };

struct DenseOrder {
    int nM, nN, nwg, G, c;
    __device__ void init(int nM_, int nN_, int G_, int c_) { nM = nM_; nN = nN_; nwg = nM * nN; G = G_; c = c_; }
    __device__ bool tile(int i, int& pm, int& pn) const {
        const int L = i * G + c; if (L >= nwg) return false;
        int wgid = L; { const int q = nwg / NXCD, r = nwg % NXCD, xcd = wgid % NXCD, off = wgid / NXCD; wgid = (xcd < r ? xcd * (q + 1) : r * (q + 1) + (xcd - r) * q) + off; }
        const int nig = WGM * nN, gid = wgid / nig, fm = gid * WGM, gsz = (nM - fm) < WGM ? (nM - fm) : WGM;
        pm = fm + ((wgid % nig) % gsz); pn = (wgid % nig) / gsz; return true;
    }
    __device__ bool next(int i, Unit& u) const { if (!tile(i, u.pm, u.pn)) return false; u.arow = u.pm * BM; u.brow = u.pn * BM; u.e = 0; return true; }
    __device__ __forceinline__ void a_ready(const Unit&) const {}
    __device__ __forceinline__ void done(const Unit&) const {}
};
struct MoeOrder : DenseOrder {
    const PG8_LAS int* tile_e; int nrows_e;
    __device__ bool next(int i, Unit& u) const { if (!tile(i, u.pm, u.pn)) return false; u.e = __builtin_amdgcn_readfirstlane(tile_e[u.pm]); u.arow = u.pm * BM; u.brow = u.e * nrows_e + u.pn * BM; return true; }
};
typedef int i32x8 __attribute__((ext_vector_type(8)));
typedef int i32x4 __attribute__((ext_vector_type(4)));
__device__ __forceinline__ i32x8 cat8(const bf16x8 lo, const bf16x8 hi) { const i32x4 a = __builtin_bit_cast(i32x4, lo), b = __builtin_bit_cast(i32x4, hi); return __builtin_shufflevector(a, b, 0, 1, 2, 3, 4, 5, 6, 7); }
__device__ __forceinline__ unsigned pk4_fp8(float a, float b, float c, float d) {
    a = __builtin_amdgcn_fmed3f(a, -448.f, 448.f); b = __builtin_amdgcn_fmed3f(b, -448.f, 448.f); c = __builtin_amdgcn_fmed3f(c, -448.f, 448.f); d = __builtin_amdgcn_fmed3f(d, -448.f, 448.f);
    int w = 0; w = __builtin_amdgcn_cvt_pk_fp8_f32(a, b, w, false); w = __builtin_amdgcn_cvt_pk_fp8_f32(c, d, w, true); return (unsigned)w; }
constexpr float W8_SCALE = 64.f, W8_INV = 1.f / 64.f;
__device__ __forceinline__ u32x4 pack8(const f32x4 v0, const f32x4 v1) { u32x4 w; w.x = cvt_pk_bf16(v0[0], v0[1]); w.y = cvt_pk_bf16(v0[2], v0[3]); w.z = cvt_pk_bf16(v1[0], v1[1]); w.w = cvt_pk_bf16(v1[2], v1[3]); return w; }
__device__ __forceinline__ void unpack8(const u32x4 w, f32x4& v0, f32x4& v1) { v0 = (f32x4){bf_lo(w.x), bf_hi(w.x), bf_lo(w.y), bf_hi(w.y)}; v1 = (f32x4){bf_lo(w.z), bf_hi(w.z), bf_lo(w.w), bf_hi(w.w)}; }
__device__ __forceinline__ f32x4 sig4(const f32x4 x) { return (f32x4){sigmoidf_(x[0]), sigmoidf_(x[1]), sigmoidf_(x[2]), sigmoidf_(x[3])}; }

struct EpiBf16 {
    static constexpr bool PERM = true, AFTER_DRAIN = false;
    bf16_t* O; int ldc; const float* bias; int bias_stride_e; float scale;
    __device__ __forceinline__ void operator()(const f32x4 (&acc)[2][2][4][2], const Unit& u, int wr, int wc, int fr, int fq) const {
        const int row0 = u.arow + wr * 64 + fr, col0 = u.pn * BM + wc * 32 + 8 * fq;
        f32x4 bv[2][2];
#pragma unroll
        for (int bj = 0; bj < 2; ++bj)
#pragma unroll
            for (int n = 0; n < 2; ++n) bv[bj][n] = bias ? *(const f32x4*)(bias + (size_t)u.e * bias_stride_e + col0 + bj * HALF + 4 * n) : (f32x4){0.f, 0.f, 0.f, 0.f};
#pragma unroll
        for (int ai = 0; ai < 2; ++ai)
#pragma unroll
            for (int m = 0; m < 4; ++m) { bf16_t* rowp = O + (size_t)(row0 + ai * HALF + m * 16) * ldc + col0;
#pragma unroll
                for (int bj = 0; bj < 2; ++bj) *(u32x4*)(rowp + bj * HALF) = pack8(acc[ai][bj][m][0] * scale + bv[bj][0], acc[ai][bj][m][1] * scale + bv[bj][1]); }
    }
};
struct EpiF8 {
    static constexpr bool PERM = true, AFTER_DRAIN = false;
    unsigned char* O; int ldc; const float* bias; int bias_stride_e; float scale;
    __device__ __forceinline__ void operator()(const f32x4 (&acc)[2][2][4][2], const Unit& u, int wr, int wc, int fr, int fq) const {
        const int row0 = u.arow + wr * 64 + fr, col0 = u.pn * BM + wc * 32 + 8 * fq;
        f32x4 bv[2][2];
#pragma unroll
        for (int bj = 0; bj < 2; ++bj)
#pragma unroll
            for (int n = 0; n < 2; ++n) bv[bj][n] = *(const f32x4*)(bias + (size_t)u.e * bias_stride_e + col0 + bj * HALF + 4 * n);
#pragma unroll
        for (int ai = 0; ai < 2; ++ai)
#pragma unroll
            for (int m = 0; m < 4; ++m) { unsigned char* rowp = O + (size_t)(row0 + ai * HALF + m * 16) * ldc + col0;
#pragma unroll
                for (int bj = 0; bj < 2; ++bj) { const f32x4 v0 = acc[ai][bj][m][0] * scale + bv[bj][0], v1 = acc[ai][bj][m][1] * scale + bv[bj][1];
                    u32x2 w; w.x = pk4_fp8(v0[0], v0[1], v0[2], v0[3]); w.y = pk4_fp8(v1[0], v1[1], v1[2], v1[3]); *(u32x2*)(rowp + bj * HALF) = w; } }
    }
};
template <int MODE> struct EpiGate {
    static constexpr bool PERM = true, AFTER_DRAIN = false;
    const bf16_t* gate; int gld; float* tmp; bf16_t* O; int ldc;
    __device__ __forceinline__ void operator()(const f32x4 (&acc)[2][2][4][2], const Unit& u, int wr, int wc, int fr, int fq) const {
        const int row0 = u.arow + wr * 64 + fr, col0 = u.pn * BM + wc * 32 + 8 * fq;
#pragma unroll
        for (int ai = 0; ai < 2; ++ai)
#pragma unroll
            for (int m = 0; m < 4; ++m) { const size_t row = (size_t)(row0 + ai * HALF + m * 16);
#pragma unroll
                for (int bj = 0; bj < 2; ++bj) { const int col = col0 + bj * HALF;
                    f32x4 g0, g1; unpack8(*(const u32x4*)(gate + row * gld + col), g0, g1);
                    f32x4 v0 = sig4(g0) * acc[ai][bj][m][0], v1 = sig4(g1) * acc[ai][bj][m][1];
                    if (MODE == 1) { *(f32x4*)(tmp + row * ldc + col) = v0; *(f32x4*)(tmp + row * ldc + col + 4) = v1; }
                    else { if (MODE == 2) { v0 += *(const f32x4*)(tmp + row * ldc + col); v1 += *(const f32x4*)(tmp + row * ldc + col + 4); }
                        *(u32x4*)(O + row * ldc + col) = pack8(v0, v1); } }
                asm volatile("" ::: "memory"); }
    }
};
struct NoMid { static constexpr bool ON = false; __device__ __forceinline__ void operator()(f32x4 (&)[2][2][4][2], const Unit&, int, int, int, int) const {} };
struct MidGate {
    static constexpr bool ON = true;
    const bf16_t* ga; const bf16_t* gb; int gld;
    __device__ __forceinline__ void operator()(f32x4 (&acc)[2][2][4][2], const Unit& u, int wr, int wc, int fr, int fq) const {
        const int row0 = u.arow + wr * 64 + fr, col0 = u.pn * BM + wc * 32 + 8 * fq;
#pragma unroll
        for (int ai = 0; ai < 2; ++ai)
#pragma unroll
            for (int m = 0; m < 4; ++m) { const size_t row = (size_t)(row0 + ai * HALF + m * 16);
#pragma unroll
                for (int bj = 0; bj < 2; ++bj) { const int col = col0 + bj * HALF;
                    f32x4 a0, a1, b0, b1; unpack8(*(const u32x4*)(ga + row * gld + col), a0, a1); unpack8(*(const u32x4*)(gb + row * gld + col), b0, b1);
#pragma unroll
                    for (int j = 0; j < 4; ++j) { acc[ai][bj][m][0][j] *= (1.f + __expf(-fmaxf(b0[j], -30.f))) * __builtin_amdgcn_rcpf(1.f + __expf(-a0[j])); acc[ai][bj][m][1][j] *= (1.f + __expf(-fmaxf(b1[j], -30.f))) * __builtin_amdgcn_rcpf(1.f + __expf(-a1[j])); } }
                asm volatile("" ::: "memory"); }
    }
};
struct EpiGateOut {
    static constexpr bool PERM = true, AFTER_DRAIN = false;
    const bf16_t* gate; int gld; bf16_t* O; int ldc;
    __device__ __forceinline__ void operator()(const f32x4 (&acc)[2][2][4][2], const Unit& u, int wr, int wc, int fr, int fq) const {
        const int row0 = u.arow + wr * 64 + fr, col0 = u.pn * BM + wc * 32 + 8 * fq;
#pragma unroll
        for (int ai = 0; ai < 2; ++ai)
#pragma unroll
            for (int m = 0; m < 4; ++m) { const size_t row = (size_t)(row0 + ai * HALF + m * 16);
#pragma unroll
                for (int bj = 0; bj < 2; ++bj) { const int col = col0 + bj * HALF;
                    f32x4 g0, g1; unpack8(*(const u32x4*)(gate + row * gld + col), g0, g1);
#pragma unroll
                    for (int j = 0; j < 4; ++j) { g0[j] = fmaxf(g0[j], -30.f); g1[j] = fmaxf(g1[j], -30.f); }
                    *(u32x4*)(O + row * ldc + col) = pack8(sig4(g0) * acc[ai][bj][m][0], sig4(g1) * acc[ai][bj][m][1]); }
                asm volatile("" ::: "memory"); }
    }
};
struct EpiResid {
    static constexpr bool PERM = false, AFTER_DRAIN = false;
    const float* base; float* out; int ldc;
    __device__ __forceinline__ void operator()(const f32x4 (&acc)[2][2][4][2], const Unit& u, int wr, int wc, int fr, int fq) const {
        const int row0 = u.arow + wr * 64 + fr, col0 = u.pn * BM + wc * 32 + 4 * fq;
#pragma unroll
        for (int ai = 0; ai < 2; ++ai)
#pragma unroll
            for (int m = 0; m < 4; ++m) { const size_t off = (size_t)(row0 + ai * HALF + m * 16) * ldc + col0;
#pragma unroll
                for (int bj = 0; bj < 2; ++bj)
#pragma unroll
                    for (int n = 0; n < 2; ++n) *(f32x4*)(out + off + bj * HALF + n * 16) = *(const f32x4*)(base + off + bj * HALF + n * 16) + acc[ai][bj][m][n];
                asm volatile("" ::: "memory"); }
    }
};
__device__ __forceinline__ f32x2 pk_fma(f32x2 a, f32x2 b, f32x2 c) { f32x2 r; asm("v_pk_fma_f32 %0, %1, %2, %3" : "=v"(r) : "v"(a), "v"(b), "v"(c)); return r; }
__device__ __forceinline__ f32x2 pk_mul(f32x2 a, f32x2 b) { f32x2 r; asm("v_pk_mul_f32 %0, %1, %2" : "=v"(r) : "v"(a), "v"(b)); return r; }
__device__ __forceinline__ f32x2 pk_add(f32x2 a, f32x2 b) { f32x2 r; asm("v_pk_add_f32 %0, %1, %2" : "=v"(r) : "v"(a), "v"(b)); return r; }
__device__ __forceinline__ f32x2 pk_mul_t(f32x2 a, f32x2 b) { f32x2 r; asm("s_nop 0\n\tv_pk_mul_f32 %0, %1, %2" : "=v"(r) : "v"(a), "v"(b)); return r; }
__device__ __forceinline__ f32x2 pk_add_t(f32x2 a, f32x2 b) { f32x2 r; asm("s_nop 0\n\tv_pk_add_f32 %0, %1, %2" : "=v"(r) : "v"(a), "v"(b)); return r; }
template <bool O8> struct EpiSwiglu {
    static constexpr bool PERM = true, AFTER_DRAIN = false;
    void* O; int ldc; const float* bias; float scale;
    __device__ __forceinline__ void operator()(const f32x4 (&acc)[2][2][4][2], const Unit& u, int wr, int wc, int fr, int fq) const {
        const int row0 = u.arow + wr * 64 + fr, cin = wc * 32 + 8 * fq, ocol = u.pn * HALF + cin;
        const float* bp = bias + (size_t)u.e * 4096 + u.pn * BM + cin;
        f32x4 bg[2], bl[2];
#pragma unroll
        for (int n = 0; n < 2; ++n) { bg[n] = *(const f32x4*)(bp + 4 * n); bl[n] = *(const f32x4*)(bp + HALF + 4 * n); }
        const f32x2 sc2 = {scale, scale}, one2 = {1.f, 1.f}, ce2 = {-1.702f * 1.4426950408889634f, -1.702f * 1.4426950408889634f};
#pragma unroll
        for (int ai = 0; ai < 2; ++ai)
#pragma unroll
            for (int m = 0; m < 4; ++m) { f32x4 a[2];
#pragma unroll
                for (int n = 0; n < 2; ++n) { const f32x4 G = acc[ai][0][m][n], L = acc[ai][1][m][n];
#pragma unroll
                    for (int h = 0; h < 2; ++h) {
                        f32x2 g = pk_fma((f32x2){G[2 * h], G[2 * h + 1]}, sc2, (f32x2){bg[n][2 * h], bg[n][2 * h + 1]}), l = pk_fma((f32x2){L[2 * h], L[2 * h + 1]}, sc2, (f32x2){bl[n][2 * h], bl[n][2 * h + 1]});
                        g[0] = __builtin_amdgcn_fmed3f(g[0], -3.0e38f, 7.f); g[1] = __builtin_amdgcn_fmed3f(g[1], -3.0e38f, 7.f);     l[0] = __builtin_amdgcn_fmed3f(l[0], -7.f, 7.f); l[1] = __builtin_amdgcn_fmed3f(l[1], -7.f, 7.f);
                        f32x2 t = pk_mul(g, ce2); t[0] = __builtin_amdgcn_exp2f(t[0]); t[1] = __builtin_amdgcn_exp2f(t[1]); t = pk_add_t(t, one2); t[0] = __builtin_amdgcn_rcpf(t[0]); t[1] = __builtin_amdgcn_rcpf(t[1]);
                        const f32x2 o = pk_mul(pk_mul_t(g, t), pk_add(l, one2)); a[n][2 * h] = o[0]; a[n][2 * h + 1] = o[1]; } }
                const size_t off = (size_t)(row0 + ai * HALF + m * 16) * ldc + ocol;
                if constexpr (O8) { u32x2 w; w.x = pk4_fp8(a[0][0], a[0][1], a[0][2], a[0][3]); w.y = pk4_fp8(a[1][0], a[1][1], a[1][2], a[1][3]); *(u32x2*)((unsigned char*)O + off) = w; }
                else *(u32x4*)((bf16_t*)O + off) = pack8(a[0], a[1]); }
    }
};

struct EpiProj {
    static constexpr bool PERM = true, AFTER_DRAIN = false;
    bf16_t* proj; bf16_t* qn; bf16_t* kn; const float* wq; const float* wk; PG8_LAS float* ss; bf16_t* vn;
    __device__ __forceinline__ void operator()(const f32x4 (&acc)[2][2][4][2], const Unit& u, int wr, int wc, int fr, int fq) const {
        const int rloc = wr * 64 + fr, cin = wc * 32 + 8 * fq;
        if (u.pn >= 8) {
            const bool isv = u.pn < 12; const size_t pitch = isv ? (size_t)1024 : (size_t)NPROJ;
            bf16_t* o = (isv ? vn + (u.pn - 8) * BM : proj + u.pn * BM) + (size_t)(u.arow + rloc) * pitch + cin;
#pragma unroll
            for (int ai = 0; ai < 2; ++ai)
#pragma unroll
                for (int m = 0; m < 4; ++m) { bf16_t* rowp = o + (size_t)(ai * HALF + m * 16) * pitch;
#pragma unroll
                    for (int bj = 0; bj < 2; ++bj) *(u32x4*)(rowp + bj * HALF) = pack8(acc[ai][bj][m][0], acc[ai][bj][m][1]); }
        } else {
#pragma unroll
            for (int ai = 0; ai < 2; ++ai)
#pragma unroll
                for (int m = 0; m < 4; ++m)
#pragma unroll
                    for (int bj = 0; bj < 2; ++bj) { const f32x4 a = acc[ai][bj][m][0], b = acc[ai][bj][m][1];
                        float p = ((a[0] * a[0] + a[1] * a[1]) + (a[2] * a[2] + a[3] * a[3])) + ((b[0] * b[0] + b[1] * b[1]) + (b[2] * b[2] + b[3] * b[3]));
                        p += __shfl_xor(p, 16); p += __shfl_xor(p, 32);
                        if (fq == 0) ss[((ai * HALF + m * 16 + rloc) * 2 + bj) * 4 + wc] = p; }
            asm volatile("s_waitcnt lgkmcnt(0)" ::: "memory"); __builtin_amdgcn_s_barrier();
            const float* w = (u.pn < 4 ? wq : wk) + cin; const f32x4 w0 = *(const f32x4*)w, w1 = *(const f32x4*)(w + 4);
            bf16_t* o = (u.pn < 4 ? qn : kn) + (size_t)(u.arow + rloc) * 1024 + (u.pn & 3) * BM + cin;
#pragma unroll
            for (int ai = 0; ai < 2; ++ai)
#pragma unroll
                for (int m = 0; m < 4; ++m) { const f32x4 s0 = *(const PG8_LAS f32x4*)(ss + (ai * HALF + m * 16 + rloc) * 8), s1 = *(const PG8_LAS f32x4*)(ss + (ai * HALF + m * 16 + rloc) * 8 + 4);
                    const float r0 = rsqrtf(((s0[0] + s0[1]) + (s0[2] + s0[3])) * (1.f / 128.f) + 1e-6f), r1 = rsqrtf(((s1[0] + s1[1]) + (s1[2] + s1[3])) * (1.f / 128.f) + 1e-6f);
                    bf16_t* rowp = o + (size_t)(ai * HALF + m * 16) * 1024;
                    *(u32x4*)rowp = pack8(acc[ai][0][m][0] * r0 * w0, acc[ai][0][m][1] * r0 * w1);
                    *(u32x4*)(rowp + HALF) = pack8(acc[ai][1][m][0] * r1 * w0, acc[ai][1][m][1] * r1 * w1); }
            asm volatile("s_waitcnt lgkmcnt(0)" ::: "memory"); __builtin_amdgcn_s_barrier();
        }
    }
};
struct EpiSig {
    static constexpr bool PERM = true, AFTER_DRAIN = false;
    bf16_t* O; int ldc_unused; float scale;
    __device__ __forceinline__ void operator()(const f32x4 (&acc)[2][2][4][2], const Unit& u, int wr, int wc, int fr, int fq) const {
        const float lo = (u.pn >> 3) ? -30.f : -88.f;
        unsigned char* base = (unsigned char*)(O + (size_t)(u.arow + wr * 64 + fr) * NPROJ + (u.pn * BM + wc * 32 + 8 * fq));
#pragma unroll
        for (int ai = 0; ai < 2; ++ai)
#pragma unroll
            for (int m = 0; m < 4; ++m) {
#pragma unroll
                for (int bj = 0; bj < 2; ++bj) { f32x4 s0, s1;
#pragma unroll
                    for (int j = 0; j < 4; ++j) { s0[j] = __builtin_amdgcn_rcpf(1.f + __expf(-fmaxf(acc[ai][bj][m][0][j] * scale, lo))); s1[j] = __builtin_amdgcn_rcpf(1.f + __expf(-fmaxf(acc[ai][bj][m][1][j] * scale, lo))); }
                    *(u32x4*)(base + ((size_t)(ai * HALF + m * 16) * NPROJ + bj * HALF) * 2) = pack8(s0, s1); }
                asm volatile("" ::: "memory"); }
    }
};
struct MidGateS {
    static constexpr bool ON = true;
    const bf16_t* ga; const bf16_t* gb; int gld;
    __device__ __forceinline__ void operator()(f32x4 (&acc)[2][2][4][2], const Unit& u, int wr, int wc, int fr, int fq) const {
        const int row0 = u.arow + wr * 64 + fr, col0 = u.pn * BM + wc * 32 + 8 * fq;
#pragma unroll
        for (int ai = 0; ai < 2; ++ai)
#pragma unroll
            for (int m = 0; m < 4; ++m) { const size_t row = (size_t)(row0 + ai * HALF + m * 16);
#pragma unroll
                for (int bj = 0; bj < 2; ++bj) { const int col = col0 + bj * HALF;
                    f32x4 a0, a1, b0, b1; unpack8(*(const u32x4*)(ga + row * gld + col), a0, a1); unpack8(*(const u32x4*)(gb + row * gld + col), b0, b1);
#pragma unroll
                    for (int j = 0; j < 4; ++j) { acc[ai][bj][m][0][j] *= a0[j] * __builtin_amdgcn_rcpf(b0[j]); acc[ai][bj][m][1][j] *= a1[j] * __builtin_amdgcn_rcpf(b1[j]); } }
                asm volatile("" ::: "memory"); }
    }
};
struct EpiGateOutS {
    static constexpr bool PERM = true, AFTER_DRAIN = false;
    const bf16_t* gate; int gld; bf16_t* O; int ldc;
    __device__ __forceinline__ void operator()(const f32x4 (&acc)[2][2][4][2], const Unit& u, int wr, int wc, int fr, int fq) const {
        const int row0 = u.arow + wr * 64 + fr, col0 = u.pn * BM + wc * 32 + 8 * fq;
#pragma unroll
        for (int ai = 0; ai < 2; ++ai)
#pragma unroll
            for (int m = 0; m < 4; ++m) { const size_t row = (size_t)(row0 + ai * HALF + m * 16);
#pragma unroll
                for (int bj = 0; bj < 2; ++bj) { const int col = col0 + bj * HALF;
                    f32x4 g0, g1; unpack8(*(const u32x4*)(gate + row * gld + col), g0, g1);
                    *(u32x4*)(O + row * ldc + col) = pack8(g0 * acc[ai][bj][m][0], g1 * acc[ai][bj][m][1]); }
                asm volatile("" ::: "memory"); }
    }
};
struct EpiSigRS {
    static constexpr bool PERM = true, AFTER_DRAIN = false;
    bf16_t* OR; bf16_t* OS; float scale;
    __device__ __forceinline__ void operator()(const f32x4 (&acc)[2][2][4][2], const Unit& u, int wr, int wc, int fr, int fq) const {
        const size_t o0 = (size_t)(u.arow + wr * 64 + fr) * NPROJ + (u.pn * HALF + wc * 32 + 8 * fq);
        unsigned char* pr = (unsigned char*)(OR + o0); unsigned char* ps = (unsigned char*)(OS + o0);
#pragma unroll
        for (int ai = 0; ai < 2; ++ai)
#pragma unroll
            for (int m = 0; m < 4; ++m) { f32x4 r[2], s[2];
#pragma unroll
                for (int n = 0; n < 2; ++n)
#pragma unroll
                    for (int j = 0; j < 4; ++j) { const float eb = 1.f + __expf(-fmaxf(acc[ai][1][m][n][j] * scale, -30.f)); s[n][j] = __builtin_amdgcn_rcpf(eb); r[n][j] = eb * __builtin_amdgcn_rcpf(1.f + __expf(-fmaxf(acc[ai][0][m][n][j] * scale, -88.f))); }
                *(u32x4*)(pr + (size_t)(ai * HALF + m * 16) * NPROJ * 2) = pack8(r[0], r[1]); *(u32x4*)(ps + (size_t)(ai * HALF + m * 16) * NPROJ * 2) = pack8(s[0], s[1]);
                asm volatile("" ::: "memory"); }
    }
};
struct MidGateR {
    static constexpr bool ON = true;
    const bf16_t* gr; int gld;
    __device__ __forceinline__ void operator()(f32x4 (&acc)[2][2][4][2], const Unit& u, int wr, int wc, int fr, int fq) const {
        const int row0 = u.arow + wr * 64 + fr, col0 = u.pn * BM + wc * 32 + 8 * fq;
#pragma unroll
        for (int ai = 0; ai < 2; ++ai)
#pragma unroll
            for (int m = 0; m < 4; ++m) { const size_t row = (size_t)(row0 + ai * HALF + m * 16);
#pragma unroll
                for (int bj = 0; bj < 2; ++bj) { f32x4 a0, a1; unpack8(*(const u32x4*)(gr + row * gld + col0 + bj * HALF), a0, a1); acc[ai][bj][m][0] *= a0; acc[ai][bj][m][1] *= a1; }
                asm volatile("" ::: "memory"); }
    }
};
template <class Epi, class Sched, bool ALIGN_EPI = false, bool SP2 = false, bool F8 = false, class Mid = NoMid, bool GATHER = false>
__device__ __forceinline__ void gemm_phase(PG8_LAS unsigned char* lds, const Gemm g, const Sched& S, const Epi& E, const Mid& M = Mid()) {
    const int tid = threadIdx.x, wid = __builtin_amdgcn_readfirstlane(tid >> 6), lane = tid & 63, wr = wid >> 2, wc = wid & 3, fr = lane & 15, fq = lane >> 4;
    const int K = g.K, nt = K / BK;
    unsigned voffA[2], voffB[2];
#pragma unroll
    for (int i = 0; i < 2; ++i) { int R, C; stage_rc(tid * 16 + i * 8192, R, C); const int Rb = Epi::PERM ? ((R & ~31) + perm32(R & 31)) : R;
        voffA[i] = (unsigned)(R * K + C) * 2u; voffB[i] = (unsigned)(Rb * K + C) * 2u; }
    const size_t kstep = (size_t)(BK * 2);
    const size_t hstep = (size_t)HALF * K * 2;
    const size_t hstepA = GATHER ? (size_t)0 : hstep; static_assert(!GATHER || SP2, "GATHER is wired into the SP2 loop only");
    const unsigned ldsw = (unsigned)wid * 1024u;
    const int aoff = lds_byte(wr * 64 + fr, fq * 8), boff = lds_byte(wc * 32 + fr, fq * 8);
#define PG8_SA(b, h) (((b) * 2 + (h)) * HTB)
#define PG8_SB(b, h) ((4 + (b) * 2 + (h)) * HTB)
#define PG8_STAGE(bufoff, gbase, voff) do { _Pragma("unroll") for (int _i = 0; _i < 2; ++_i) { unsigned _vo = (voff)[_i]; asm volatile("" : "+v"(_vo));     \
        __builtin_amdgcn_global_load_lds((const unsigned*)((const char*)(gbase) + _vo), (PG8_LAS unsigned*)(lds + (bufoff) + ldsw + _i * 8192), 16, 0, 0); } } while (0)
#define PG8_LDA(dst, b, h) do { _Pragma("unroll") for (int m = 0; m < 4; ++m) _Pragma("unroll") for (int k = 0; k < 2; ++k) dst[m][k] = *(const PG8_LAS bf16x8*)(lds + PG8_SA(b, h) + aoff + m * 2048 + k * 1024); } while (0)
#define PG8_LDB(dst, b, h) do { _Pragma("unroll") for (int n = 0; n < 2; ++n) _Pragma("unroll") for (int k = 0; k < 2; ++k) dst[n][k] = *(const PG8_LAS bf16x8*)(lds + PG8_SB(b, h) + boff + n * 2048 + k * 1024); } while (0)
#define PG8_MMA(ai, bj, At, Bt) do { __builtin_amdgcn_s_setprio(1); \
        if constexpr (F8) { _Pragma("unroll") for (int m = 0; m < 4; ++m) _Pragma("unroll") for (int n = 0; n < 2; ++n) \
            acc[ai][bj][m][n] = __builtin_amdgcn_mfma_scale_f32_16x16x128_f8f6f4(cat8(Bt[n][0], Bt[n][1]), cat8(At[m][0], At[m][1]), acc[ai][bj][m][n], 0, 0, 0, 0, 0, 0); }     \
        else { _Pragma("unroll") for (int m = 0; m < 4; ++m) _Pragma("unroll") for (int n = 0; n < 2; ++n) _Pragma("unroll") for (int k = 0; k < 2; ++k) \
            acc[ai][bj][m][n] = __builtin_amdgcn_mfma_f32_16x16x32_bf16(Bt[n][k], At[m][k], acc[ai][bj][m][n], 0, 0, 0); } \
        __builtin_amdgcn_s_setprio(0); } while (0)
#define PG8_WAIT_V(n) asm volatile("s_waitcnt vmcnt(" #n ")" ::: "memory")
#define PG8_WAIT_L(n) asm volatile("s_waitcnt lgkmcnt(" #n ")" ::: "memory")
#define PG8_BAR __builtin_amdgcn_s_barrier()
#define PG8_SCHED __builtin_amdgcn_sched_barrier(0)
    Unit cur, nxt; int ui = 0;
    if (!S.next(0, cur)) return;
    f32x4 acc[2][2][4][2];
#pragma unroll
    for (int a = 0; a < 2; ++a)
#pragma unroll
        for (int b = 0; b < 2; ++b)
#pragma unroll
            for (int m = 0; m < 4; ++m)
#pragma unroll
                for (int n = 0; n < 2; ++n) acc[a][b][m][n] = (f32x4){0.f, 0.f, 0.f, 0.f};
    bf16x8 At[4][2], B0[2][2], B1[2][2];
    unsigned va[2][2];
#pragma unroll
    for (int h = 0; h < 2; ++h) { va[h][0] = voffA[0]; va[h][1] = voffA[1]; }
#define PG8_GLOADH(uidx, h) do { int _t; asm volatile("v_mov_b32 %0, %1" : "=v"(_t) : "v"(tid)); const int _sb = (_t & 63) * 16, _sw = _sb ^ (((_sb >> 9) & 1) << 5), _st = _t >> 6; \
        const int _R = (_st >> 1) * 16 + (_sw >> 6); const unsigned _C2 = (unsigned)(((_st & 1) * 32 + ((_sw & 63) >> 1)) * 2); const PG8_LAS unsigned short* _tp = g.rowtab + (uidx) * 256 + (h) * 128 + _R; \
        va[h][0] = (unsigned)_tp[0] * (unsigned)(K * 2) + _C2; va[h][1] = (unsigned)_tp[64] * (unsigned)(K * 2) + _C2; } while (0)
    const size_t rstep = (size_t)K * 2;
    const char* cA = (const char*)g.A + (GATHER ? (size_t)0 : (size_t)cur.arow * rstep); const char* cB = (const char*)g.Bt + (size_t)cur.brow * rstep;
    S.a_ready(cur);
    if constexpr (GATHER) { PG8_GLOADH(0, 0); PG8_GLOADH(0, 1); }
    if constexpr (SP2) {
        PG8_STAGE(PG8_SB(0, 0), cB, voffB); PG8_STAGE(PG8_SB(0, 1), cB + hstep, voffB); PG8_STAGE(PG8_SA(0, 0), cA, va[0]); PG8_STAGE(PG8_SA(0, 1), cA + hstepA, va[1]);
        if (wr == 1) PG8_BAR;
        PG8_WAIT_V(2); PG8_BAR;
        PG8_STAGE(PG8_SB(1, 0), cB + kstep, voffB); PG8_STAGE(PG8_SA(1, 0), cA + kstep, va[0]); PG8_STAGE(PG8_SB(1, 1), cB + hstep + kstep, voffB);
        PG8_WAIT_V(6); PG8_BAR;
    } else {
        PG8_STAGE(PG8_SB(0, 0), cB, voffB); PG8_STAGE(PG8_SA(0, 0), cA, voffA); PG8_STAGE(PG8_SB(0, 1), cB + hstep, voffB); PG8_STAGE(PG8_SA(0, 1), cA + hstep, voffA);
        if (wr == 1) PG8_BAR;
        PG8_WAIT_V(4); PG8_BAR;
        PG8_STAGE(PG8_SB(1, 0), cB + kstep, voffB); PG8_STAGE(PG8_SA(1, 0), cA + kstep, voffA); PG8_STAGE(PG8_SB(1, 1), cB + hstep + kstep, voffB);
        PG8_WAIT_V(6); PG8_BAR;
    }
    for (;;) {
        const bool has_next = S.next(ui + 1, nxt);
        const char* nA = (has_next && !GATHER) ? (const char*)g.A + (size_t)nxt.arow * rstep : cA; const char* nB = has_next ? (const char*)g.Bt + (size_t)nxt.brow * rstep : cB;
        for (int t = 0; t < nt; t += 2) {
            const bool last = (t == nt - 2);
            const char* a1 = cA + (size_t)(t + 1) * kstep;
            const char* a2 = last ? nA : cA + (size_t)(t + 2) * kstep; const char* b2 = last ? nB : cB + (size_t)(t + 2) * kstep;
            const char* a3 = a2 + kstep; const char* b3 = b2 + kstep;
            if (last && has_next) S.a_ready(nxt);
            if constexpr (GATHER) { if (last && has_next) PG8_GLOADH(ui + 1, 0); }
            if constexpr (Mid::ON) { if (t == nt / 2) { int lq; asm volatile("v_mov_b32 %0, %1" : "=v"(lq) : "v"(lane)); M(acc, cur, wr, wc, lq & 15, lq >> 4); } }
            if constexpr (SP2) {
            PG8_LDB(B0, 0, 0); PG8_LDB(B1, 0, 1); PG8_SCHED; PG8_LDA(At, 0, 0); PG8_STAGE(PG8_SA(1, 1), a1 + hstepA, va[1]);
            if constexpr (GATHER) { if (last && has_next) PG8_GLOADH(ui + 1, 1); }
            PG8_WAIT_V(8); PG8_WAIT_L(0); PG8_BAR; PG8_MMA(0, 0, At, B0); PG8_MMA(0, 1, At, B1); PG8_BAR; PG8_SCHED;
            PG8_LDA(At, 0, 1); PG8_STAGE(PG8_SB(0, 0), b2, voffB); PG8_STAGE(PG8_SB(0, 1), b2 + hstep, voffB); PG8_STAGE(PG8_SA(0, 0), a2, va[0]);
            PG8_WAIT_V(8); PG8_WAIT_L(0); PG8_BAR; PG8_MMA(1, 0, At, B0); PG8_MMA(1, 1, At, B1); PG8_BAR; PG8_SCHED;
            PG8_LDB(B0, 1, 0); PG8_LDB(B1, 1, 1); PG8_SCHED; PG8_LDA(At, 1, 0); PG8_STAGE(PG8_SA(0, 1), a2 + hstepA, va[1]);
            PG8_WAIT_V(8); PG8_WAIT_L(0); PG8_BAR; PG8_MMA(0, 0, At, B0); PG8_MMA(0, 1, At, B1); PG8_BAR; PG8_SCHED;
            PG8_LDA(At, 1, 1); PG8_STAGE(PG8_SB(1, 0), b3, voffB); PG8_STAGE(PG8_SB(1, 1), b3 + hstep, voffB); PG8_STAGE(PG8_SA(1, 0), a3, va[0]);
            PG8_WAIT_V(8); PG8_WAIT_L(0); PG8_BAR; PG8_MMA(1, 0, At, B0); PG8_MMA(1, 1, At, B1); PG8_BAR; PG8_SCHED;
            } else {
            PG8_LDB(B0, 0, 0); PG8_SCHED; PG8_LDA(At, 0, 0); PG8_STAGE(PG8_SA(1, 1), a1 + hstep, voffA);
            PG8_WAIT_L(8); PG8_BAR; PG8_WAIT_L(0); PG8_MMA(0, 0, At, B0); PG8_BAR; PG8_SCHED;
            PG8_LDB(B1, 0, 1); PG8_STAGE(PG8_SB(0, 0), b2, voffB);
            PG8_BAR; PG8_WAIT_L(0); PG8_MMA(0, 1, At, B1); PG8_BAR;
            PG8_LDA(At, 0, 1); PG8_STAGE(PG8_SA(0, 0), a2, voffA);
            PG8_BAR; PG8_WAIT_L(0); PG8_MMA(1, 0, At, B0); PG8_BAR; PG8_SCHED;
            PG8_STAGE(PG8_SB(0, 1), b2 + hstep, voffB);
            PG8_WAIT_V(6); PG8_BAR; PG8_MMA(1, 1, At, B1); PG8_BAR;
            PG8_LDB(B0, 1, 0); PG8_SCHED; PG8_LDA(At, 1, 0); PG8_STAGE(PG8_SA(0, 1), a2 + hstep, voffA);
            PG8_WAIT_L(8); PG8_BAR; PG8_WAIT_L(0); PG8_MMA(0, 0, At, B0); PG8_BAR; PG8_SCHED;
            PG8_LDB(B1, 1, 1); PG8_STAGE(PG8_SB(1, 0), b3, voffB);
            PG8_BAR; PG8_WAIT_L(0); PG8_MMA(0, 1, At, B1); PG8_BAR;
            PG8_LDA(At, 1, 1); PG8_STAGE(PG8_SA(1, 0), a3, voffA);
            PG8_BAR; PG8_WAIT_L(0); PG8_MMA(1, 0, At, B0); PG8_BAR; PG8_SCHED;
            PG8_STAGE(PG8_SB(1, 1), b3 + hstep, voffB);
            PG8_WAIT_V(6); PG8_BAR; PG8_MMA(1, 1, At, B1); PG8_BAR;
            }
        }
        if constexpr (ALIGN_EPI) { if (wr == 0) PG8_BAR; }
        if constexpr (!Epi::AFTER_DRAIN) { int lq; asm volatile("v_mov_b32 %0, %1" : "=v"(lq) : "v"(lane)); E(acc, cur, wr, wc, lq & 15, lq >> 4); S.done(cur); }
        if (!has_next) break;
#pragma unroll
        for (int a = 0; a < 2; ++a)
#pragma unroll
            for (int b = 0; b < 2; ++b)
#pragma unroll
                for (int m = 0; m < 4; ++m)
#pragma unroll
                    for (int n = 0; n < 2; ++n) acc[a][b][m][n] = (f32x4){0.f, 0.f, 0.f, 0.f};
        cur = nxt; cA = nA; cB = nB; ++ui;
        if constexpr (ALIGN_EPI) { if (wr == 1) PG8_BAR; }
    }
    PG8_WAIT_V(0);
    if constexpr (!ALIGN_EPI) { if (wr == 0) PG8_BAR; }
    PG8_BAR;
    if constexpr (Epi::AFTER_DRAIN) { E.fused(acc, cur, wr, wc, fr, fq, lds, wid, lane); S.done(cur); }
#undef PG8_SA
#undef PG8_SB
#undef PG8_STAGE
#undef PG8_LDA
#undef PG8_GLOADH
#undef PG8_LDB
#undef PG8_MMA
#undef PG8_WAIT_V
#undef PG8_WAIT_L
#undef PG8_BAR
#undef PG8_SCHED
}
}

namespace attn {
constexpr int D = 128; constexpr float THR = 8.f; constexpr bool WSKIP = false;
constexpr float SCALE = 0.08838834764831845f;
constexpr int NW = 8, QBLK = 32, KVBLK = 64, QB = NW * QBLK;
constexpr int SHM_V = KVBLK * D * 2, SHM_K = KVBLK * D * 2;
constexpr int LDS_BYTES = 2 * SHM_V + 2 * SHM_K + NW * 64 * 4;

typedef short bf16x8 __attribute__((ext_vector_type(8)));
typedef short s16x4 __attribute__((ext_vector_type(4)));
typedef float f32x16 __attribute__((ext_vector_type(16)));
typedef float f32x4 __attribute__((ext_vector_type(4)));
typedef unsigned u32x4 __attribute__((ext_vector_type(4)));
template <class A, class Bt> struct same_t { static constexpr bool v = false; };
template <class A> struct same_t<A, A> { static constexpr bool v = true; };

__device__ __forceinline__ int opaque_tid() { int t; asm volatile("v_mov_b32 %0, %1" : "=v"(t) : "v"(threadIdx.x)); return t; }
#define KSWZ(row, colB) ((row) * 256 + ((colB) ^ (((row) & 7) << 4)))
#define SBAR() __builtin_amdgcn_sched_barrier(0)
__device__ __forceinline__ int v_st(int k, int c) { const int kk = (k & ~0xC) | ((k & 4) << 1) | ((k & 8) >> 1); return ((kk >> 3) * 4 + (c >> 5)) * 512 + ((kk & 7) * 32 + (c & 31)) * 2; }
__device__ __forceinline__ int v_rd_base(int lane) { return ((lane & 3) << 3) | (((lane >> 2) & 3) << 6) | (((lane >> 4) & 1) << 5) | (((lane >> 5) & 1) << 8); }
constexpr int v_rd_off(int d0, int ks, int half) { return d0 * 512 + ks * 4096 + half * 2048; }
__device__ __forceinline__ int crow(int r, int hi) { return (r & 3) + 8 * (r >> 2) + 4 * hi; }
__device__ __forceinline__ unsigned cvtpk(float lo, float hi) {
    unsigned r; asm volatile("v_cvt_pk_bf16_f32 %0, %1, %2" : "=v"(r) : "v"(lo), "v"(hi)); return r;
}
__device__ __forceinline__ bf16x8 pack8(f32x4 a, f32x4 b) {
    u32x4 w = {cvtpk(a[0], a[1]), cvtpk(a[2], a[3]), cvtpk(b[0], b[1]), cvtpk(b[2], b[3])};
    return *reinterpret_cast<bf16x8*>(&w);
}
template <class T> __device__ __forceinline__ bf16x8 load8(const T* p) {
    if constexpr (same_t<T, float>::v) { return pack8(*(const f32x4*)p, *(const f32x4*)(p + 4)); }
    else { return *reinterpret_cast<const bf16x8*>(p); }
}
__device__ __forceinline__ void mask_tile(f32x16& p0, f32x16& p1, int dq, unsigned W) {
    const float NEG = -__builtin_inff();
#pragma unroll
    for (int r = 0; r < 16; ++r) {
        const int c = (r & 3) + 8 * (r >> 2);
        if ((unsigned)(dq - c) >= W) p0[r] = NEG;
        if ((unsigned)(dq - c - 32) >= W) p1[r] = NEG;
    }
}
__device__ __forceinline__ void partialSM(f32x16& p0, f32x16& p1, float& m_reg, float& mn, float& alpha) {
    float pmax = p0[0]; for (int r = 1; r < 16; ++r) pmax = fmaxf(pmax, p0[r]); for (int r = 0; r < 16; ++r) pmax = fmaxf(pmax, p1[r]);
    { auto rr = __builtin_amdgcn_permlane32_swap(__float_as_uint(pmax), __float_as_uint(pmax), false, false);
      pmax = fmaxf(__uint_as_float(rr[0]), __uint_as_float(rr[1])); }
    constexpr float C2 = 1.4426950408889634f * SCALE;
    if (__builtin_expect(__all((pmax - m_reg) * SCALE <= THR), 1)) { mn = m_reg; alpha = 1.f; }
    else { mn = fmaxf(m_reg, pmax); alpha = __builtin_amdgcn_exp2f((m_reg - mn) * C2); m_reg = mn; }
    const float mnL = -mn * C2;
    for (int r = 0; r < 16; ++r) p0[r] = fmaf(p0[r], C2, mnL); for (int r = 0; r < 16; ++r) p1[r] = fmaf(p1[r], C2, mnL);
    for (int r = 0; r < 16; ++r) p0[r] = __builtin_amdgcn_exp2f(p0[r]);
}
__device__ __forceinline__ void finishSM(f32x16& p0, f32x16& p1, float alpha, float& l_reg, bf16x8& pa0, bf16x8& pa1, bf16x8& pa2, bf16x8& pa3) {
    for (int r = 0; r < 16; ++r) p1[r] = __builtin_amdgcn_exp2f(p1[r]);
    float ps = 0; for (int r = 0; r < 16; ++r) ps += p0[r]; for (int r = 0; r < 16; ++r) ps += p1[r];
    { auto rr = __builtin_amdgcn_permlane32_swap(__float_as_uint(ps), __float_as_uint(ps), false, false);
      ps = __uint_as_float(rr[0]) + __uint_as_float(rr[1]); }
    l_reg = l_reg * alpha + ps;
#define PK4(P, B_, OUT) do { unsigned a0 = cvtpk(P[B_+0], P[B_+1]), a1 = cvtpk(P[B_+2], P[B_+3]);                          \
        unsigned b0 = cvtpk(P[B_+4], P[B_+5]), b1 = cvtpk(P[B_+6], P[B_+7]);                                             \
        auto r0 = __builtin_amdgcn_permlane32_swap(a0, b0, false, false); auto r1 = __builtin_amdgcn_permlane32_swap(a1, b1, false, false); \
        u32x4 w = {r0[0], r1[0], r0[1], r1[1]}; OUT = *reinterpret_cast<bf16x8*>(&w); } while (0)
    PK4(p0, 0, pa0); PK4(p0, 8, pa1); PK4(p1, 0, pa2); PK4(p1, 8, pa3);
#undef PK4
}
template <int KB, bool SK>
__device__ __forceinline__ void qkt(f32x16& p0, f32x16& p1, const char* K_lds, int r32, int hi, const bf16x8* qr, bool act, const float* cbt) {
    if (SK && !act) { const float NEG = -__builtin_inff();
#pragma unroll
        for (int r = 0; r < 16; ++r) { p0[r] = NEG; p1[r] = NEG; } return; }
#pragma unroll
    for (int g = 0; g < 4; ++g) { const f32x4 b0 = *(const f32x4*)(cbt + 8 * g), b1 = *(const f32x4*)(cbt + 32 + 8 * g);
        p0[4 * g] = b0[0]; p0[4 * g + 1] = b0[1]; p0[4 * g + 2] = b0[2]; p0[4 * g + 3] = b0[3]; p1[4 * g] = b1[0]; p1[4 * g + 1] = b1[1]; p1[4 * g + 2] = b1[2]; p1[4 * g + 3] = b1[3]; }
    const char* kb[4];
#pragma unroll
    for (int dd = 0; dd < 4; ++dd) kb[dd] = K_lds + KB * SHM_K + KSWZ(r32, (dd * 16 + hi * 8) * 2);
#pragma unroll
    for (int d0 = 0; d0 < 8; ++d0) { const char* a = kb[d0 & 3] + (d0 >> 2) * 128;
        bf16x8 b0 = *reinterpret_cast<const bf16x8*>(a);
        bf16x8 b1 = *reinterpret_cast<const bf16x8*>(a + 32 * 256);
        p0 = __builtin_amdgcn_mfma_f32_32x32x16_bf16(b0, qr[d0], p0, 0, 0, 0);
        p1 = __builtin_amdgcn_mfma_f32_32x32x16_bf16(b1, qr[d0], p1, 0, 0, 0); }
}
template <int VB, bool SK>
__device__ __forceinline__ void pv_tile(f32x16* o, int vb0, bf16x8 pa0, bf16x8 pa1, bf16x8 pa2, bf16x8 pa3, bool act) {
    if (SK && !act) return;
#define TRRD(dst, off) asm volatile("ds_read_b64_tr_b16 %0, %1 offset:%2" : "=&v"(dst) : "v"(vb0), "i"(off) : "memory")
#define PV_D0(d0) do { s16x4 l0, l1, l2, l3, h0, h1, h2, h3; constexpr int b_ = VB * SHM_V + v_rd_off(d0, 0, 0);     \
        TRRD(l0, b_); TRRD(h0, b_ + 2048); TRRD(l1, b_ + 4096); TRRD(h1, b_ + 6144); TRRD(l2, b_ + 8192); TRRD(h2, b_ + 10240); TRRD(l3, b_ + 12288); TRRD(h3, b_ + 14336); \
        asm volatile("s_waitcnt lgkmcnt(0)" ::: "memory"); SBAR();                 \
        o[d0] = __builtin_amdgcn_mfma_f32_32x32x16_bf16(pa0, (bf16x8){l0[0], l0[1], l0[2], l0[3], h0[0], h0[1], h0[2], h0[3]}, o[d0], 0, 0, 0);   \
        o[d0] = __builtin_amdgcn_mfma_f32_32x32x16_bf16(pa1, (bf16x8){l1[0], l1[1], l1[2], l1[3], h1[0], h1[1], h1[2], h1[3]}, o[d0], 0, 0, 0);   \
        o[d0] = __builtin_amdgcn_mfma_f32_32x32x16_bf16(pa2, (bf16x8){l2[0], l2[1], l2[2], l2[3], h2[0], h2[1], h2[2], h2[3]}, o[d0], 0, 0, 0);   \
        o[d0] = __builtin_amdgcn_mfma_f32_32x32x16_bf16(pa3, (bf16x8){l3[0], l3[1], l3[2], l3[3], h3[0], h3[1], h3[2], h3[3]}, o[d0], 0, 0, 0); } while (0)
    PV_D0(0); PV_D0(1); PV_D0(2); PV_D0(3);
#undef PV_D0
#undef TRRD
}

template <class TIn, class TOut> struct BlockRef { const TIn* Q; const TIn* K; const TIn* V; TOut* O; const float* CB; int P0; int JL; };
template <class TIn> struct Seam {
    bf16x8 qr[8];
    bf16x8 st_v0, st_v1, st_k0, st_k1; f32x4 sf0, sf1, sf2, sf3;
    f32x4 tq[16];
};
__device__ __forceinline__ int swa_jlo(int P0, int W) { const int lowk = P0 - W + 1; return lowk > 0 ? lowk / KVBLK : 0; }
#define ROWK(p, k0, rr) ((p) + (size_t)((k0) + (rr)) * KP + sc)
#define ROWV(p, k0, rr) ((p) + (size_t)((k0) + (rr)) * VP + sc)
#define VMW() asm volatile("s_waitcnt vmcnt(0)" ::: "memory")
#define VMWN(n) asm volatile("s_waitcnt vmcnt(%0)" :: "i"(n) : "memory")
#define SLOAD_H(Kp, Vp, k0) do { S.st_v0 = load8<TIn>(ROWV(Vp, k0, sr)); S.st_v1 = load8<TIn>(ROWV(Vp, k0, 32 + sr));              \
                         S.st_k0 = load8<TIn>(ROWK(Kp, k0, sr)); S.st_k1 = load8<TIn>(ROWK(Kp, k0, 32 + sr)); } while (0)
#define SWRITE_HK(bf) do { *(bf16x8*)(K_lds + (bf) * SHM_K + kws) = S.st_k0; *(bf16x8*)(K_lds + (bf) * SHM_K + kws + 32 * 256) = S.st_k1; } while (0)
#define SWRITE_HV(bf) do { *(bf16x8*)(V_lds + (bf) * SHM_V + vst0) = S.st_v0; *(bf16x8*)(V_lds + (bf) * SHM_V + vst1) = S.st_v1; } while (0)
#define SWRITE_H(bf) do { SWRITE_HV(bf); SWRITE_HK(bf); } while (0)
#define SLOAD_F(p, k0) do { S.sf0 = *(const f32x4*)ROWK(p, k0, sr); S.sf1 = *(const f32x4*)(ROWK(p, k0, sr) + 4);                \
                            S.sf2 = *(const f32x4*)ROWK(p, k0, 32 + sr); S.sf3 = *(const f32x4*)(ROWK(p, k0, 32 + sr) + 4); } while (0)
#define SWRITE_KF(bf) do { *(bf16x8*)(K_lds + (bf) * SHM_K + kws) = pack8(S.sf0, S.sf1); *(bf16x8*)(K_lds + (bf) * SHM_K + kws + 32 * 256) = pack8(S.sf2, S.sf3); } while (0)
#define SWRITE_VF(bf) do { *(bf16x8*)(V_lds + (bf) * SHM_V + vst0) = pack8(S.sf0, S.sf1); *(bf16x8*)(V_lds + (bf) * SHM_V + vst1) = pack8(S.sf2, S.sf3); } while (0)
template <class TIn, class TOut, int QP, int KP, int VP, int OP>
__device__ __forceinline__ void causal_swa_prime(const BlockRef<TIn, TOut>& cur, int W, char* lds, Seam<TIn>& S) {
    constexpr bool F32 = same_t<TIn, float>::v;
    const int tid = opaque_tid(), wid = __builtin_amdgcn_readfirstlane(tid >> 6), lane = tid & 63, r32 = lane & 31, hi = lane >> 5;
    const int sr = tid >> 4, sc = (tid & 15) * 8, kws = KSWZ(sr, sc * 2); char* K_lds = lds + 2 * SHM_V;
    const int kb0 = cur.JL * KVBLK;
    for (int d0 = 0; d0 < 8; ++d0) S.qr[d0] = load8<TIn>(cur.Q + (size_t)(wid * QBLK + r32) * QP + d0 * 16 + hi * 8);
    if constexpr (F32) { SLOAD_F((const float*)cur.K, kb0); VMW(); SWRITE_KF(0); SBAR(); SLOAD_F((const float*)cur.V, kb0); }
    else { SLOAD_H(cur.K, cur.V, kb0); VMW(); SWRITE_HK(0); }
    __syncthreads();
}
template <class TIn, class TOut, int QP, int KP, int VP, int OP>
__device__ __forceinline__ void causal_swa_block(const BlockRef<TIn, TOut>& cur, const BlockRef<TIn, TOut>& nxt, int skv, int W, char* lds, Seam<TIn>& S) {
    constexpr bool F32 = same_t<TIn, float>::v;
    const int tid = opaque_tid(), wid = __builtin_amdgcn_readfirstlane(tid >> 6), lane = tid & 63, r32 = lane & 31, hi = lane >> 5;
    const int j_lo = cur.JL;
    int j_hi = (cur.P0 + QB - 1) / KVBLK + 1; if (j_hi > skv / KVBLK) j_hi = skv / KVBLK;
    const int NT = j_hi - j_lo;
    const int kbn = nxt.JL * KVBLK;
    const int qlo = cur.P0 + wid * QBLK, qm = qlo + r32 - 4 * hi;
    char* V_lds = lds; char* K_lds = lds + 2 * SHM_V;
    float* ws = (float*)(lds + 2 * SHM_V + 2 * SHM_K) + wid * 64; float* li_l = ws, * al_l = ws + 32;
    float m_reg = -1e30f, l_reg = 0; f32x16 o[4] = {};
    float* cbl_w = (float*)(lds + 2 * SHM_V + 2 * SHM_K + NW * 64 * 4);
    { const int n4 = (cur.P0 + QB) / 4; for (int i = 16 * cur.JL + tid; i < n4; i += 64 * NW) ((f32x4*)cbl_w)[i] = ((const f32x4*)cur.CB)[i]; }
    __syncthreads();
    const float* cbl = cbl_w + 4 * hi;
    const int sr = tid >> 4, sc = (tid & 15) * 8, vst0 = v_st(sr, sc), vst1 = v_st(32 + sr, sc), kws = KSWZ(sr, sc * 2);
    const int vb0 = (int)(uintptr_t)V_lds + v_rd_base(lane);
    const TIn* Kh = cur.K; const TIn* Vh = cur.V;
#define RESC(a) do { if (__any((a) < 1.f)) { if (hi == 0) al_l[r32] = (a); asm volatile("s_waitcnt lgkmcnt(0)" ::: "memory");              \
                     for (int d_ = 0; d_ < 4; ++d_) for (int r = 0; r < 16; ++r) o[d_][r] *= al_l[crow(r, hi)]; } } while (0)
#define KBASE(t) ((j_lo + (t)) * KVBLK)
#define ACT(t) (KBASE(t) <= qlo + QBLK - 1 && KBASE(t) + KVBLK - 1 >= qlo - W + 1)
#define MASKT(P0_, P1_, t) do { const int kb_ = KBASE(t); if ((!SK || ACT(t)) && (kb_ + KVBLK - 1 > qlo || kb_ <= qlo + QBLK - 1 - W)) mask_tile(P0_, P1_, qm - kb_, (unsigned)W); } while (0)
    constexpr int NQL = F32 ? 16 : 8;
    constexpr bool SK = WSKIP && !F32;
#define SEAM_K0() do { VMWN(NQL); if constexpr (F32) { SWRITE_KF(0); SBAR(); SLOAD_F((const float*)nxt.V, kbn); } else { SWRITE_HK(0); } SBAR(); } while (0)
    f32x16 pA0, pA1, pB0, pB1; float mnA, mnB, alA, alB; bf16x8 pa0, pa1, pa2, pa3;
    if constexpr (F32) { VMW(); SWRITE_VF(0); SBAR(); } else { SWRITE_HV(0); SBAR(); }
    if (NT > 1) { if constexpr (F32) SLOAD_F((const float*)Kh, KBASE(1)); else SLOAD_H(Kh, Vh, KBASE(1)); }
    SBAR(); qkt<0, SK>(pA0, pA1, K_lds, r32, hi, S.qr, ACT(0), cbl + KBASE(0));
    if constexpr (F32) { if (NT > 1) { VMW(); SWRITE_KF(1); SBAR(); SLOAD_F((const float*)Vh, KBASE(1)); } }
    MASKT(pA0, pA1, 0); partialSM(pA0, pA1, m_reg, mnA, alA);
    if (NT > 1) { VMW(); if constexpr (F32) { SWRITE_VF(1); SBAR(); if (NT > 2) SLOAD_F((const float*)Kh, KBASE(2)); } else SWRITE_H(1); }
    __syncthreads();
#define HALF_STEP(PX0, PX1, mnX, alX, PY0, PY1, alY, t, KB, VB, SB) do {                                                      \
        SBAR(); qkt<KB, SK>(PX0, PX1, K_lds, r32, hi, S.qr, ACT(t), cbl + KBASE(t));                                             \
        finishSM(PY0, PY1, alY, l_reg, pa0, pa1, pa2, pa3); SBAR();                                                           \
        if ((t) + 1 < NT) { if constexpr (F32) { VMW(); SWRITE_KF(SB); SBAR(); SLOAD_F((const float*)Vh, KBASE((t) + 1)); }  \
                            else { SLOAD_H(Kh, Vh, KBASE((t) + 1)); } SBAR(); }                                               \
        pv_tile<VB, SK>(o, vb0, pa0, pa1, pa2, pa3, ACT((t) - 1)); MASKT(PX0, PX1, (t)); partialSM(PX0, PX1, m_reg, mnX, alX);                                        \
        __syncthreads();                                                                                                      \
        if ((t) + 1 < NT) { VMW(); if constexpr (F32) { SWRITE_VF(SB); SBAR(); if ((t) + 2 < NT) SLOAD_F((const float*)Kh, KBASE((t) + 2)); } \
                            else { SWRITE_H(SB); } }                                                                          \
        RESC(alX); __syncthreads(); } while (0)
    for (int t = 1; t + 1 < NT; t += 2) {
        HALF_STEP(pB0, pB1, mnB, alB, pA0, pA1, alA, t, 1, 0, 0);
        HALF_STEP(pA0, pA1, mnA, alA, pB0, pB1, alB, t + 1, 0, 1, 1);
    }
    const bool even = (NT & 1) == 0;
    if (even) { SBAR(); qkt<1, SK>(pB0, pB1, K_lds, r32, hi, S.qr, ACT(NT - 1), cbl + KBASE(NT - 1)); SBAR(); }
#define QROW(e) (nxt.Q + (size_t)(wid * QBLK + r32) * QP + ((e) >> 1) * 16 + hi * 8 + ((e) & 1) * 4)
    if constexpr (F32) { SLOAD_F((const float*)nxt.K, kbn); SBAR();
#pragma unroll
        for (int e = 0; e < 8; ++e) S.tq[e] = *(const f32x4*)QROW(e); }
    else { SLOAD_H(nxt.K, nxt.V, kbn); SBAR();
#pragma unroll
        for (int d0 = 0; d0 < 8; ++d0) S.qr[d0] = load8<TIn>(nxt.Q + (size_t)(wid * QBLK + r32) * QP + d0 * 16 + hi * 8); }
    SBAR();
    finishSM(pA0, pA1, alA, l_reg, pa0, pa1, pa2, pa3); SBAR();
    if constexpr (F32) {
#pragma unroll
        for (int e = 8; e < 16; ++e) S.tq[e] = *(const f32x4*)QROW(e); SBAR(); }
#undef QROW
    pv_tile<0, SK>(o, vb0, pa0, pa1, pa2, pa3, ACT(even ? NT - 2 : NT - 1));
    if (even) { MASKT(pB0, pB1, NT - 1); partialSM(pB0, pB1, m_reg, mnB, alB); __syncthreads(); RESC(alB);
        finishSM(pB0, pB1, alB, l_reg, pa0, pa1, pa2, pa3); SBAR(); pv_tile<1, SK>(o, vb0, pa0, pa1, pa2, pa3, ACT(NT - 1)); }
    SBAR(); SEAM_K0();
    if (hi == 0) li_l[r32] = l_reg; asm volatile("s_waitcnt lgkmcnt(0)" ::: "memory");
    float rli[16];
#pragma unroll
    for (int r = 0; r < 16; ++r) rli[r] = __builtin_amdgcn_rcpf(li_l[crow(r, hi)]);
    TOut* Ow = cur.O + (size_t)(wid * QBLK) * OP;
#pragma unroll
    for (int r = 0; r < 16; ++r) { const int orow = crow(r, hi);
#pragma unroll
        for (int d0 = 0; d0 < 4; ++d0) { const float v = o[d0][r] * rli[r];
            if constexpr (same_t<TOut, float>::v) { Ow[(size_t)orow * OP + d0 * 32 + r32] = v; }
            else { const float vn = __shfl_xor(v, 1);
                   if ((r32 & 1) == 0) *(unsigned*)(Ow + (size_t)orow * OP + d0 * 32 + r32) = cvtpk(v, vn); } } }
    if constexpr (F32) {
#pragma unroll
        for (int d0 = 0; d0 < 8; ++d0) S.qr[d0] = pack8(S.tq[2 * d0], S.tq[2 * d0 + 1]); }
    __syncthreads();
#undef RESC
#undef KBASE
#undef ACT
#undef MASKT
#undef SEAM_K0
#undef HALF_STEP
}
#undef ROWK
#undef ROWV
#undef VMW
#undef VMWN
#undef SLOAD_H
#undef SWRITE_HK
#undef SWRITE_HV
#undef SWRITE_H
#undef SLOAD_F
#undef SWRITE_KF
#undef SWRITE_VF
}

#define XB_TMO      128
#define XB_XCNT(j)  (256  + 64 * (j))
#define XB_XSUB(j)  (1280 + 64 * (j))
#define XB_XGEN(j)  (2304 + 64 * (j))
#define XB_TOP      3328
#define XB_TOPGEN   3392
#define XCD_BAR_WORDS 3456
#define XB_SPIN_CAP (1u << 18)

__device__ __forceinline__ unsigned xb_ld(unsigned* p)              { return __hip_atomic_load(p, __ATOMIC_RELAXED, __HIP_MEMORY_SCOPE_AGENT); }
__device__ __forceinline__ unsigned xb_add(unsigned* p, unsigned v) { return __hip_atomic_fetch_add(p, v, __ATOMIC_RELAXED, __HIP_MEMORY_SCOPE_AGENT); }
__device__ __forceinline__ unsigned xb_xcc_id() { return (unsigned)__builtin_amdgcn_s_getreg((3 << 11) | 20) & 0xFu; }
#define XB_SPIN(cond, bar) do { unsigned _sp = 0; while (cond) { __builtin_amdgcn_s_sleep(1); \
    if ((++_sp & 255u) == 0u) { if (xb_ld(&(bar)[XB_TMO])) break; if (_sp > XB_SPIN_CAP) { atomicAdd(&(bar)[XB_TMO], 1u); break; } } } } while (0)

struct XcdBarrier {
    unsigned* bar; unsigned x;
    volatile LAS unsigned* st;
};

__device__ __forceinline__ XcdBarrier xcd_barrier_post(unsigned* bar, volatile LAS unsigned* st) {
    XcdBarrier b; b.bar = bar; b.x = xb_xcc_id(); b.st = st;
    if (threadIdx.x == 0) (void)xb_add(&bar[XB_XCNT(b.x)], 1u);
    return b;
}
__device__ __forceinline__ void xcd_barrier_complete(unsigned* bar, unsigned x, unsigned& nloc, unsigned& nx) {
    const unsigned G = gridDim.x * gridDim.y * gridDim.z;
    unsigned sum, cnt, mine, sp = 0u;
    for (;;) {
        sum = 0u; cnt = 0u; mine = 0u;
#pragma unroll
        for (unsigned j = 0; j < 16; ++j) { const unsigned c = xb_ld(&bar[XB_XCNT(j)]); sum += c; cnt += (c > 0u) ? 1u : 0u; mine = (j == x) ? c : mine; }
        if (sum == G) break;
        __builtin_amdgcn_s_sleep(1);
        if ((++sp & 255u) == 0u) { if (xb_ld(&bar[XB_TMO])) break; if (sp > XB_SPIN_CAP) { atomicAdd(&bar[XB_TMO], 1u); break; } }
    }
    nloc = mine > 0u ? mine : 1u; nx = cnt > 0u ? cnt : 1u;
}

__device__ __forceinline__ void xcd_barrier(const XcdBarrier& b) {
    asm volatile("s_waitcnt vmcnt(0)" ::: "memory");
    __syncthreads();
    if (threadIdx.x == 0) {
        unsigned* bar = b.bar;
        __builtin_amdgcn_s_waitcnt(0);
        unsigned nloc = b.st[0], nx = b.st[1];
        if (nloc == 0u) { xcd_barrier_complete(bar, b.x, nloc, nx); b.st[0] = nloc; b.st[1] = nx; }
        const unsigned old = xb_add(&bar[XB_XSUB(b.x)], 1u);
        const unsigned gen = old / nloc;
        if (old + 1u == (gen + 1u) * nloc) {
            __builtin_amdgcn_fence(__ATOMIC_RELEASE, "agent");
            asm volatile("s_waitcnt vmcnt(0)" ::: "memory");
            const unsigned og = xb_add(&bar[XB_TOP], 1u);
            const unsigned tg = og / nx;
            if (og + 1u == (tg + 1u) * nx) xb_add(&bar[XB_TOPGEN], 1u);
            else XB_SPIN(xb_ld(&bar[XB_TOPGEN]) == tg, bar);
            __builtin_amdgcn_fence(__ATOMIC_ACQUIRE, "agent");
            xb_add(&bar[XB_XGEN(b.x)], 1u);
            asm volatile("s_waitcnt vmcnt(0)" ::: "memory");
        } else {
            XB_SPIN(xb_ld(&bar[XB_XGEN(b.x)]) == gen, bar);
            __builtin_amdgcn_fence(__ATOMIC_ACQUIRE, "agent");
            asm volatile("s_waitcnt vmcnt(0)" ::: "memory");
        }
    }
    __syncthreads();
}

#ifndef MK_RANGES
#define MK_RANGES 0, 13
#endif
constexpr int NPHASE = 13;

constexpr size_t MiB = 1u << 20;
constexpr size_t al(size_t x) { return (x + 4095) & ~(size_t)4095; }
constexpr size_t WS_CTL = 0, CTL_ZERO_BYTES = 1 * MiB;
constexpr size_t WS_WINT = 1 * MiB;
constexpr size_t WS_WST  = WS_WINT + al((size_t)NPROJ * DM * 2);
constexpr size_t WS_WUFT = WS_WST + al(32 * DM * 2);
constexpr size_t WS_WUGT = WS_WUFT + al((size_t)DM * FW * 2);
constexpr size_t WS_WOT  = WS_WUGT + al((size_t)DM * FW * 2);
constexpr size_t WS_WRT  = WS_WOT + al((size_t)DM * DM * 2);
constexpr size_t WS_BGU  = WS_WRT + al(32 * DM * 2);
constexpr size_t WS_WGUT = WS_BGU + al((size_t)NE * 4096 * 4);
constexpr size_t WS_WDT  = WS_WGUT + al((size_t)NE * 4096 * DM * 2);
constexpr size_t WS_H1   = WS_WDT + al((size_t)NE * DM * DFF * 2);
constexpr size_t WS_SMALLP = WS_H1 + al((size_t)T * DM * 2);
constexpr size_t WS_PROJ = WS_SMALLP + al((size_t)T * 32 * 4);
constexpr size_t WS_QN   = WS_PROJ + al((size_t)T * NPROJ * 2);
constexpr size_t WS_KN   = WS_QN + al((size_t)T * FW * 2);
constexpr size_t WS_CB   = WS_KN + al((size_t)T * FW * 2);
constexpr size_t WS_GQKV = WS_CB + al((size_t)BATCH * NH * SEQ * 4);
constexpr size_t WS_GBETA = WS_GQKV + al((size_t)T * 3072 * 2);
constexpr size_t WS_GG   = WS_GBETA + al((size_t)T * 8 * 4);
constexpr size_t WS_GU   = WS_GG + al((size_t)T * 8 * 4);
constexpr size_t WS_GW   = WS_GU + al((size_t)NUNIT * 64 * 128 * 2);
constexpr size_t WS_GQD  = WS_GW + al((size_t)NUNIT * 64 * 128 * 2);
constexpr size_t WS_GKDT = WS_GQD + al((size_t)NUNIT * 64 * 128 * 2);
constexpr size_t WS_GATT = WS_GKDT + al((size_t)NUNIT * 64 * 128 * 2);
constexpr size_t WS_GGL  = WS_GATT + al((size_t)NUNIT * 64 * 64 * 2);
constexpr size_t WS_GO   = WS_GGL + al((size_t)NUNIT * 4);
constexpr size_t WS_YF   = WS_GO + al((size_t)T * FW * 4);
constexpr size_t WS_YG   = WS_YF + al((size_t)T * FW * 2);
constexpr size_t WS_TMP  = WS_YG + al((size_t)T * FW * 2);
constexpr size_t WS_MERGED = WS_TMP + al((size_t)T * DM * 4);
constexpr size_t WS_XN2  = WS_MERGED + al((size_t)T * DM * 2);
constexpr size_t WS_TOKE = WS_XN2 + al((size_t)T * DM * 2);
constexpr size_t WS_TOKW = WS_TOKE + al((size_t)T * 4 * 4);
constexpr size_t WS_TOKP = WS_TOKW + al((size_t)T * 4 * 4);
constexpr size_t WS_XS   = WS_TOKP + al((size_t)T * 4 * 4);
constexpr size_t WS_XN8  = WS_XS;
constexpr size_t WS_TOS  = WS_XS + (size_t)T * DM;
constexpr size_t WS_ACT  = WS_XS + al((size_t)MAXSLOT * DM * 2);
constexpr size_t WS_YB   = WS_ACT + al((size_t)MAXSLOT * DFF * 2);
constexpr size_t WS_H8   = WS_YB + al((size_t)MAXSLOT * DM * 2);
constexpr size_t WS_WIN8 = WS_H8 + al((size_t)T * DM);
constexpr size_t WS_VN   = WS_WIN8 + al((size_t)4096 * DM);
constexpr size_t WS_END  = WS_VN + al((size_t)T * FW * 2);
constexpr int CW_BAR = 4096;
constexpr int CW_CNT = 16384;
constexpr int CW_QP2 = 17408, CW_P2DONE = 19520;
constexpr int CW_QC = 18432, CW_P1DONE = 19456;
constexpr int CW_Q = 20480;
constexpr int CW_TS = 131072;
static_assert((CW_CNT + 64 * NE) * 4 <= (int)CTL_ZERO_BYTES, "CTL words inside the memset region");

constexpr int RING_OFF = 0, RING_BYTES = 151552;
constexpr int LDSCTL_OFF = RING_BYTES, MISC_OFF = LDSCTL_OFF + 320;
constexpr int TAB_OFF = MISC_OFF + 128;
constexpr int LDS_BYTES = 163840;
constexpr int TLD_OFF = TAB_OFF + 1536;
static_assert(TLD_OFF + 18 * 512 <= LDS_BYTES && 8 * 64 * 65 * 4 <= RING_BYTES, "LDS map");

struct Frame {
    LAS unsigned char* lds;
    volatile LAS unsigned* MISC;
    gu32* ctl;
    unsigned char* ws;
    int tid, lane, wave, G;
    const float* in[20]; float* out;
};
enum { I_X = 0, I_N1W, I_WIN, I_BFF, I_QNW, I_KNW, I_CONVW, I_ALOG, I_DTB, I_ONW, I_WUF, I_WUG, I_WO, I_N2W, I_WR, I_BR, I_WGU, I_BGU, I_WD, I_BD };
#define WSP(T_, off) ((T_*)(F.ws + (off)))

__device__ __forceinline__ void tr_item(const float* src, int ld, bf16* dst, int Kdst, int k0, int drow0, int mode, LAS float* scr, int lane) {
    f32x4 v[16];
    const float* p = src + (size_t)(lane >> 4) * ld + (lane & 15) * 4;
#pragma unroll
    for (int i = 0; i < 16; ++i) v[i] = __builtin_nontemporal_load((const f32x4*)(p + (size_t)(4 * i) * ld));
#pragma unroll
    for (int i = 0; i < 16; ++i) { LAS float* s = scr + (4 * i + (lane >> 4)) * 65 + (lane & 15) * 4; s[0] = v[i][0]; s[1] = v[i][1]; s[2] = v[i][2]; s[3] = v[i][3]; }
    LDS_WAIT(); asm volatile("" ::: "memory");
    const int c = lane & 7;
#pragma unroll
    for (int it = 0; it < 8; ++it) { const int ns = (lane >> 3) + 8 * it; const LAS float* s = scr + (8 * c) * 65 + ns;
        u32x4 o; o.x = cvt_pk_bf16(s[0 * 65], s[1 * 65]); o.y = cvt_pk_bf16(s[2 * 65], s[3 * 65]); o.z = cvt_pk_bf16(s[4 * 65], s[5 * 65]); o.w = cvt_pk_bf16(s[6 * 65], s[7 * 65]);
        int drow;
        if (mode == 0) drow = drow0 + ns; else { const int cs = drow0 + ns, j = cs >> 1; drow = 256 * (j >> 7) + 128 * (cs & 1) + (j & 127); }
        *(u32x4*)(dst + (size_t)drow * Kdst + k0 + 8 * c) = o; }
    LDS_WAIT(); asm volatile("" ::: "memory");
}
#ifndef CONV_PLAIN_LOADS
#define CONV_LOAD(p) __builtin_nontemporal_load(p)
#else
#define CONV_LOAD(p) (*(p))
#endif
__device__ __forceinline__ void tr8_load(f32x4 (&v)[16], const float* src, int ld, int hk, int lane) {
    const float* p = src + (size_t)(32 * hk + 16 * (lane >> 5)) * ld + (lane & 31) * 4;
#pragma unroll
    for (int i = 0; i < 16; ++i) v[i] = CONV_LOAD((const f32x4*)(p + (size_t)i * ld));
}
__device__ __forceinline__ void tr8_proc(const f32x4 (&v)[16], LAS unsigned char* tile, int hk, int lane) {
    const float k = pg8::W8_SCALE; const int nq = lane & 31, c = 2 * hk + (lane >> 5);
#pragma unroll
    for (int e = 0; e < 4; ++e) { u32x4 o;
#pragma unroll
        for (int m = 0; m < 4; ++m) o[m] = pg8::pk4_fp8(v[4 * m][e] * k, v[4 * m + 1][e] * k, v[4 * m + 2][e] * k, v[4 * m + 3][e] * k);
        *(LAS u32x4*)(tile + (4 * nq + e) * 128 + ((c ^ (nq & 7)) << 4)) = o; }
}
__device__ __forceinline__ void tr_item8(const float* src, int ld, unsigned char* dst, int Kdst, int k0, int drow0, int mode, LAS float* scr, int lane) {
    LAS unsigned char* tile = (LAS unsigned char*)scr; f32x4 va[16], vb[16];
    tr8_load(va, src, ld, 0, lane);
    tr8_load(vb, src, ld, 1, lane); tr8_proc(va, tile, 0, lane);
    tr8_load(va, src, ld, 2, lane); tr8_proc(vb, tile, 1, lane);
    tr8_load(vb, src, ld, 3, lane); tr8_proc(va, tile, 2, lane);
    tr8_proc(vb, tile, 3, lane);
    LDS_WAIT(); asm volatile("" ::: "memory");
    const int ch = lane & 7;
#pragma unroll
    for (int it = 0; it < 16; ++it) { const int row = (lane >> 3) + 8 * it; const u32x4 o = *(const LAS u32x4*)(tile + row * 128 + (ch << 4));
        int drow;
        if (mode == 0) drow = drow0 + row; else { const int cs = drow0 + row, j = cs >> 1; drow = 256 * (j >> 7) + 128 * (cs & 1) + (j & 127); }
        __builtin_nontemporal_store(o, (u32x4*)(dst + (size_t)drow * Kdst + k0 + ((ch ^ ((row >> 2) & 7)) << 4))); }
    LDS_WAIT(); asm volatile("" ::: "memory");
}
constexpr int KD = MOE_F8_DN ? 8 : 32, KG = MOE_F8_GU ? 8 : 32;
constexpr int CV3 = 16 * 32, CV4 = 16 * 32, CV5 = 32 * 32, CV6 = NE * KD * 32, CV7 = NE * KG * 64, NCONV_W = CV3 + CV4 + CV5 + CV6 + CV7, CONV_WPI = 8, NCONV_WG = NCONV_W / CONV_WPI;
static_assert(NCONV_W % (8 * CONV_WPI) == 0, "conversion items split over 8 queues of workgroup items");
__device__ __forceinline__ void conv_wave_item(Frame& F, int r, LAS float* scr) {
    const float* src; int ld, nn, Kdst; bf16* dst;
    if (r < CV3) { src = F.in[I_WUF]; ld = DM; nn = 32; dst = WSP(bf16, WS_WUFT); Kdst = DM; }
    else if ((r -= CV3) < CV4) { src = F.in[I_WUG]; ld = DM; nn = 32; dst = WSP(bf16, WS_WUFT) + FW; Kdst = DM; }
    else if ((r -= CV4) < CV5) { src = F.in[I_WO]; ld = DM; nn = 32; dst = WSP(bf16, WS_WOT); Kdst = DM; }
    else if ((r -= CV5) < CV6) { const int e = r / (KD * 32); r -= e * (KD * 32);
#if MOE_F8_DN
        const int kb = 2 * (r / 16), nb = 2 * (r % 16);
#else
        const int kb = (r / 32) * (32 / KD), nb = r % 32;
#endif
        const float* sp = F.in[I_WD] + (size_t)e * DFF * DM + (size_t)(64 * kb) * DM + 64 * nb;
#if MOE_F8_DN
        tr_item8(sp, DM, WSP(unsigned char, WS_WDT) + (size_t)e * DM * DFF, DFF, 64 * kb, 64 * nb, 0, scr, F.lane);
#else
        tr_item(sp, DM, WSP(bf16, WS_WDT) + (size_t)e * DM * DFF, DFF, 64 * kb, 64 * nb, 0, scr, F.lane);
#endif
        return; }
    else { r -= CV6; const int e = r / (KG * 64); r -= e * (KG * 64);
#if MOE_F8_GU
        const int kb = 2 * (r / 32), nb = 2 * (r % 32);
#else
        const int kb = (r / 64) * (32 / KG), nb = r % 64;
#endif
        const float* sp = F.in[I_WGU] + (size_t)e * DM * 4096 + (size_t)(64 * kb) * 4096 + 64 * nb;
#if MOE_F8_GU
        tr_item8(sp, 4096, WSP(unsigned char, WS_WGUT) + (size_t)e * 4096 * DM, DM, 64 * kb, 64 * nb, 1, scr, F.lane);
#else
        tr_item(sp, 4096, WSP(bf16, WS_WGUT) + (size_t)e * 4096 * DM, DM, 64 * kb, 64 * nb, 1, scr, F.lane);
#endif
        return; }
    const int kb = r / nn, nb = r - kb * nn;
    tr_item(src + (size_t)(64 * kb) * ld + 64 * nb, ld, dst, Kdst, 64 * kb, 64 * nb, 0, scr, F.lane);
}
struct P0Buf { f32x4 x[8]; };
__device__ __forceinline__ void p0_xload(P0Buf& B, const Frame& F, int m) { const f32x4* xr = (const f32x4*)(F.in[I_X] + (size_t)m * DM) + F.lane;
#pragma unroll
    for (int j = 0; j < 8; ++j) B.x[j] = xr[64 * j]; }
__device__ __forceinline__ void p0_xrow(const P0Buf& B, const Frame& F, int m) {
    const f32x4* nw = (const f32x4*)F.in[I_N1W] + F.lane; float ss = 0.f;
#pragma unroll
    for (int j = 0; j < 8; ++j) ss += (B.x[j][0] * B.x[j][0] + B.x[j][1] * B.x[j][1]) + (B.x[j][2] * B.x[j][2] + B.x[j][3] * B.x[j][3]);
    const float rs = rsqrtf(wave_sum(ss) * (1.f / DM) + RMS_EPS);
    u32x2* o8 = (u32x2*)(WSP(bf16, WS_H1) + (size_t)m * DM) + F.lane;
#pragma unroll
    for (int j = 0; j < 8; ++j) { const f32x4 w = nw[64 * j], v = B.x[j]; u32x2 o; o.x = cvt_pk_bf16(v[0] * rs * w[0], v[1] * rs * w[1]); o.y = cvt_pk_bf16(v[2] * rs * w[2], v[3] * rs * w[3]); o8[64 * j] = o;
#if GATES_F8
        ((unsigned*)(WSP(unsigned char, WS_H8) + (size_t)m * DM))[F.lane + 64 * j] = pg8::pk4_fp8(v[0] * rs * w[0], v[1] * rs * w[1], v[2] * rs * w[2], v[3] * rs * w[3]);
#endif
    }
}
__device__ __forceinline__ void p0_prologue(Frame& F) {
    LAS float* scr = (LAS float*)(F.lds + RING_OFF) + F.wave * (64 * 65);
    const int gw = blockIdx.x * NWAVES + F.wave, NGW = F.G * NWAVES;
    constexpr int C0 = 32 * 48, C1 = 32 * 64, C2 = 32 * 64;
    for (int it = gw; it < C0 + C1 + C2; it += NGW) {
        int r = it; const float* src; int nn, drow;
        if (r < C0) { src = F.in[I_WIN]; nn = 48; drow = 0; }
        else if ((r -= C0) < C1) { src = F.in[I_WIN] + 3080; nn = 64; drow = 3072; }
        else { r -= C1;
#if GATES_F8
            if (r >= 16 * 32) continue; { const int kb = r / 32, nb = r - kb * 32;
              tr_item8(F.in[I_WIN] + 7192 + (size_t)(128 * kb) * IN_COLS + 128 * nb, IN_COLS, WSP(unsigned char, WS_WIN8), DM, 128 * kb, GATES_SIG == 3 ? ((nb & 15) * 256 + (nb >> 4) * 128) : 128 * nb, 0, scr, F.lane); continue; }
#endif
            src = F.in[I_WIN] + 7192; nn = 64; drow = 7168; }
        const int kb = r / nn, nb = r - kb * nn;
        tr_item(src + (size_t)(64 * kb) * IN_COLS + 64 * nb, IN_COLS, WSP(bf16, WS_WINT), DM, 64 * kb, drow + 64 * nb, 0, scr, F.lane);
    }
#if !CONV_IN_P4
#ifndef CONV_WGS
#define CONV_WGS 256
#endif
    if ((int)blockIdx.x < CONV_WGS) for (int it = gw; it < NCONV_W; it += CONV_WGS * NWAVES) conv_wave_item(F, it, scr);
#endif
    const int gt = blockIdx.x * (NWAVES * 64) + F.tid, NGT = F.G * NWAVES * 64;
    { bf16* wst = WSP(bf16, WS_WST); const float* win = F.in[I_WIN];
      for (int i = gt; i < 32 * DM; i += NGT) { const int row = i / DM, d = i - row * DM; float v = 0.f;
          if (row < 24) { const int col = row < 8 ? 3072 + row : (row < 16 ? 7176 + (row - 8) : 7184 + (row - 16)); v = win[(size_t)d * IN_COLS + col]; }
          wst[i] = f2bf(v); } }
    { bf16* wrt = WSP(bf16, WS_WRT); const float* wr = F.in[I_WR];
      for (int i = gt; i < 32 * DM; i += NGT) { const int e = i / DM, d = i - e * DM; wrt[i] = f2bf(wr[d * NE + e]); } }
    { float* bgu = WSP(float, WS_BGU); const float* b = F.in[I_BGU];
      for (int i = gt; i < NE * 4096; i += NGT) { const int e = i >> 12, c = i & 4095, pn = c >> 8, bj = (c >> 7) & 1, x = c & 127; bgu[i] = b[(size_t)e * 4096 + 2 * (128 * pn + x) + bj]; } }
    for (int m = gw; m < T; m += NGW) { P0Buf A; p0_xload(A, F, m); p0_xrow(A, F, m); }
}

template <class Post>
__device__ __forceinline__ void skinny32(Frame& F, const bf16* A, const bf16* Bt, const Post& post) {
    LAS float* red = (LAS float*)(F.lds + RING_OFF); LAS float* fin = red + 8 * 64 * 33;
    const int c = F.lane & 31, hi = F.lane >> 5, w = F.wave;
    for (int tile = blockIdx.x; tile < T / 64; tile += F.G) {
        const int row0 = tile * 64;
        f32x16 acc0 = {}, acc1 = {};
        const bf16* bp = Bt + (size_t)c * DM + 256 * w + 8 * hi; const bf16* ap = A + (size_t)(row0 + c) * DM + 256 * w + 8 * hi;
#pragma unroll 8
        for (int s = 0; s < 16; ++s) { const bf16x8 b = *(const bf16x8*)(bp + 16 * s), a0 = *(const bf16x8*)(ap + 16 * s), a1 = *(const bf16x8*)(ap + (size_t)32 * DM + 16 * s);
            acc0 = __builtin_amdgcn_mfma_f32_32x32x16_bf16(a0, b, acc0, 0, 0, 0); acc1 = __builtin_amdgcn_mfma_f32_32x32x16_bf16(a1, b, acc1, 0, 0, 0); }
#pragma unroll
        for (int r = 0; r < 16; ++r) { red[(w * 64 + crow(r, hi)) * 33 + c] = acc0[r]; red[(w * 64 + 32 + crow(r, hi)) * 33 + c] = acc1[r]; }
        __syncthreads();
#pragma unroll
        for (int q = 0; q < 4; ++q) { const int idx = F.tid + 512 * q, tok = idx >> 5, col = idx & 31; float s = 0.f;
#pragma unroll
            for (int ww = 0; ww < 8; ++ww) s += red[(ww * 64 + tok) * 33 + col];
            fin[tok * 33 + col] = s; }
        __syncthreads();
        post(row0, fin);
        __syncthreads();
    }
}
__device__ __forceinline__ float log_sigmoid(float f) { return fminf(f, 0.f) - log1p_small(__expf(-fabsf(f))); }
struct PostSmall { float* out; int tid; const float* bff; float* ts;
    __device__ __forceinline__ void operator()(int row0, const LAS float* fin) const {
#pragma unroll
        for (int q = 0; q < 4; ++q) { const int idx = tid + 512 * q, tok = idx >> 5, col = idx & 31; out[(size_t)(row0 + tok) * 32 + col] = fin[tok * 33 + col]; }
        { const int h = tid >> 6, ln = tid & 63; const float s = wave_sum(log_sigmoid(fin[ln * 33 + h] + bff[h])); if (ln == 0) ts[(row0 >> 6) * 8 + h] = s; } }
};

__device__ __forceinline__ void p2_qknorm(Frame& F, int bid) {
    const int gw = bid * NWAVES + F.wave, NGW = 256 * NWAVES; const bf16* proj = WSP(bf16, WS_PROJ);
    const int cq = 8 * F.lane; const f32x4 wq0 = *(const f32x4*)(F.in[I_QNW] + (cq & 127)), wq1 = *(const f32x4*)(F.in[I_QNW] + (cq & 127) + 4), wk0 = *(const f32x4*)(F.in[I_KNW] + (cq & 127)), wk1 = *(const f32x4*)(F.in[I_KNW] + (cq & 127) + 4);
#pragma unroll 1
    for (int m0 = gw; m0 < T; m0 += 4 * NGW) { u32x4 v[4][4];
#pragma unroll
        for (int t = 0; t < 4; ++t) { const bf16* p = proj + (size_t)(m0 + t * NGW) * NPROJ + cq; v[t][0] = *(const u32x4*)(p + PC_FQ); v[t][1] = *(const u32x4*)(p + PC_FQ + 512); v[t][2] = *(const u32x4*)(p + PC_FK); v[t][3] = *(const u32x4*)(p + PC_FK + 512); }
#pragma unroll
        for (int t = 0; t < 4; ++t)
#pragma unroll
            for (int q = 0; q < 4; ++q) { f32x4 a, b; pg8::unpack8(v[t][q], a, b);
                float ss = (a[0] * a[0] + a[1] * a[1]) + (a[2] * a[2] + a[3] * a[3]) + (b[0] * b[0] + b[1] * b[1]) + (b[2] * b[2] + b[3] * b[3]);
                ss = sum16_dpp(ss);
                const float rs = rsqrtf(ss * (1.f / HD) + RMS_EPS);
                *(u32x4*)(WSP(bf16, q < 2 ? WS_QN : WS_KN) + (size_t)(m0 + t * NGW) * FW + cq + 512 * (q & 1)) = pg8::pack8(a * rs * (q < 2 ? wq0 : wk0), b * rs * (q < 2 ? wq1 : wk1)); }
    }
}
__device__ __forceinline__ void p2_cb_tile(Frame& F, int bid) {
    const float* ts = (const float*)(F.ctl + CW_TS);
    for (int tile = bid; tile < T / 64; tile += 256) { const int b = tile >> 7, tl = tile & 127, h = F.wave, ln = F.lane;
        float v = log_sigmoid(WSP(float, WS_SMALLP)[(size_t)(tile * 64 + ln) * 32 + h] + F.in[I_BFF][h]);
#pragma unroll
        for (int o = 1; o < 64; o <<= 1) { const float t = __shfl_up(v, o); if (ln >= o) v += t; }
        float pre = (ln < tl ? ts[(b * 128 + ln) * 8 + h] : 0.f) + (64 + ln < tl ? ts[(b * 128 + 64 + ln) * 8 + h] : 0.f);
        pre = wave_sum(pre);
        WSP(float, WS_CB)[(size_t)(b * NH + h) * SEQ + tl * 64 + ln] = -(pre + v) * 11.313708498984761f; }
}
__device__ __forceinline__ void p2_cbscan(Frame& F, int bid) {
    LAS float* wt = (LAS float*)(F.lds + RING_OFF);
    for (int bh = bid; bh < BATCH * NH; bh += 256) {
        const int b = bh >> 3, h = bh & 7; const float* sp = WSP(float, WS_SMALLP) + (size_t)(b * SEQ + 16 * F.tid) * 32 + h; const float bf = F.in[I_BFF][h];
        float ls[16], run = 0.f;
#pragma unroll
        for (int i = 0; i < 16; ++i) { run += log_sigmoid(sp[i * 32] + bf); ls[i] = run; }
        float v = run;
#pragma unroll
        for (int o = 1; o < 64; o <<= 1) { const float t = __shfl_up(v, o); if (F.lane >= o) v += t; }
        if (F.lane == 63) wt[F.wave] = v;
        __syncthreads();
        float pre = v - run;
        for (int ww = 0; ww < F.wave; ++ww) pre += wt[ww];
        float* cb = WSP(float, WS_CB) + (size_t)bh * SEQ + 16 * F.tid;
#pragma unroll
        for (int i = 0; i < 16; i += 4) *(f32x4*)(cb + i) = (f32x4){-(pre + ls[i]) * 11.313708498984761f, -(pre + ls[i + 1]) * 11.313708498984761f, -(pre + ls[i + 2]) * 11.313708498984761f, -(pre + ls[i + 3]) * 11.313708498984761f};
        __syncthreads();
    }
}

typedef attn::BlockRef<bf16, bf16> ABlock;
__device__ __forceinline__ ABlock attn_ref(Frame& F, int bh, int qb, int jl) {
    const int b = bh >> 3, h = bh & 7; const size_t row0 = (size_t)b * SEQ + (size_t)qb * 256;
    ABlock r; r.Q = WSP(bf16, WS_QN) + row0 * FW + h * HD; r.O = WSP(bf16, WS_YF) + row0 * DM + h * HD;
    r.K = WSP(bf16, WS_KN) + (size_t)b * SEQ * FW + h * HD; r.V = WSP(bf16, WS_VN) + (size_t)b * SEQ * FW + h * HD;
    r.CB = WSP(float, WS_CB) + (size_t)bh * SEQ; r.P0 = qb * 256; r.JL = jl; return r;
}
__device__ __forceinline__ int dequeue(Frame& F, int head_word, int limit, int stop_word = -1, unsigned stop_at = 0u) {
    __syncthreads();
    if (F.wave == 0) { const int myx = (int)xb_xcc_id() & 7; int ln; asm volatile("v_mov_b32 %0, %1" : "=v"(ln) : "v"(F.lane));
        unsigned hv = limit; if (ln < 8) hv = __hip_atomic_load((unsigned*)(F.ctl + head_word + 64 * ln), __ATOMIC_RELAXED, __HIP_MEMORY_SCOPE_AGENT);
        unsigned long long live = __ballot(ln < 8 && hv < (unsigned)limit);
        if (stop_word >= 0) { const unsigned sv = __hip_atomic_load((unsigned*)(F.ctl + stop_word), __ATOMIC_RELAXED, __HIP_MEMORY_SCOPE_AGENT); if (__builtin_amdgcn_readfirstlane(sv) >= stop_at) live = 0ull; }
        if (ln == 0) { int item = -1;
            for (int k = 0; k < 8 && item < 0; ++k) { const int qi = (myx + k) & 7; if (!((live >> qi) & 1ull)) continue;
                const unsigned idx = __hip_atomic_fetch_add((unsigned*)(F.ctl + head_word + 64 * qi), 1u, __ATOMIC_RELAXED, __HIP_MEMORY_SCOPE_AGENT);
                if (idx < (unsigned)limit) item = qi * limit + (int)idx; }
            F.MISC[16] = (unsigned)item; }
    }
    __syncthreads();
    return (int)F.MISC[16];
}
__device__ __forceinline__ void p4_attention(Frame& F, char* lds, int qword) {
    constexpr int W = 1 << 30;
    float th;
    { const float* wq = F.in[I_QNW]; const float* wk = F.in[I_KNW]; float mq = fmaxf(fabsf(wq[F.lane]), fabsf(wq[F.lane + 64])), mk = fmaxf(fabsf(wk[F.lane]), fabsf(wk[F.lane + 64]));
#pragma unroll
      for (int o = 1; o < 64; o <<= 1) { mq = fmaxf(mq, __shfl_xor(mq, o)); mk = fmaxf(mk, __shfl_xor(mk, o)); }
      th = 11.313708498984761f * (2.f * 11.313708498984761f * mq * mk + 30.f);
      th = __builtin_bit_cast(float, __builtin_amdgcn_readfirstlane(__builtin_bit_cast(int, th))); }
    for (;;) {
        const int it = dequeue(F, qword, 64); if (it < 0) break;
        const int xq = it >> 6, i = it & 63, bh = 2 * xq + (i & 1), qb = 31 - (i >> 1);
        int jl;
        { int ln; asm volatile("v_mov_b32 %0, %1" : "=v"(ln) : "v"(F.lane)); const float* cb = WSP(float, WS_CB) + (size_t)bh * SEQ; const int nt0 = qb * 4;
          const float c0 = cb[qb * 256]; const bool s0 = ln < nt0 && (c0 - cb[64 * ln + 63] >= th), s1 = ln + 64 < nt0 && (c0 - cb[64 * (ln + 64) + 63] >= th);
          const unsigned long long b0 = __ballot(s0), b1 = __ballot(s1);
          jl = (~b0 != 0ull) ? __builtin_ctzll(~b0) : 64 + ((~b1 != 0ull) ? __builtin_ctzll(~b1) : 64); if (jl > nt0) jl = nt0; jl = __builtin_amdgcn_readfirstlane(jl); }
        const ABlock cur = attn_ref(F, bh, qb, jl); attn::Seam<bf16> S;
        attn::causal_swa_prime<bf16, bf16, FW, FW, FW, DM>(cur, W, lds, S);
        attn::causal_swa_block<bf16, bf16, FW, FW, FW, DM>(cur, cur, SEQ, W, lds, S);
    }
}
__device__ __forceinline__ void p4_conversion(Frame& F) {
    LAS float* scr = (LAS float*)(F.lds + RING_OFF) + F.wave * (64 * 65);
    for (;;) { const int it = dequeue(F, CW_QC, NCONV_WG / 8); if (it < 0) break;
#pragma unroll 1
        for (int j = 0; j < CONV_WPI / 8; ++j) conv_wave_item(F, CONV_WPI * it + 8 * j + F.wave, scr); }
}
#if HAVE_GDN
__device__ __forceinline__ float softplusf_(float x) { return fmaxf(x, 0.f) + log1p_small(__expf(-fabsf(x))); }
__device__ __forceinline__ float siluf_(float x) { return x * sigmoidf_(x); }
__device__ __forceinline__ void p2_gdn_elem(Frame& F) {
    const int gw = blockIdx.x * NWAVES + F.wave, NGW = F.G * NWAVES; const bf16* proj = WSP(bf16, WS_PROJ) + PC_GQKV; bf16* dst = WSP(bf16, WS_GQKV); const float* cw = F.in[I_CONVW];
    for (int run = gw; run < T / 8; run += NGW) {
        const int t0 = run * 8, tl = t0 & (SEQ - 1);
#pragma unroll 1
        for (int j = 0; j < 6; ++j) { const int ch = 512 * j + 8 * F.lane;
            f32x4 w[4][2];
#pragma unroll
            for (int i = 0; i < 4; ++i) { w[i][0] = *(const f32x4*)(cw + i * 3072 + ch); w[i][1] = *(const f32x4*)(cw + i * 3072 + ch + 4); }
            f32x4 xa[11][2];
#pragma unroll
            for (int r = 0; r < 11; ++r) { if (tl + r - 3 >= 0) pg8::unpack8(*(const u32x4*)(proj + (size_t)(t0 + r - 3) * NPROJ + ch), xa[r][0], xa[r][1]); else { xa[r][0] = (f32x4){0.f, 0.f, 0.f, 0.f}; xa[r][1] = xa[r][0]; } }
#pragma unroll
            for (int t = 0; t < 8; ++t) { f32x4 a = w[0][0] * xa[t][0] + w[1][0] * xa[t + 1][0] + w[2][0] * xa[t + 2][0] + w[3][0] * xa[t + 3][0], b = w[0][1] * xa[t][1] + w[1][1] * xa[t + 1][1] + w[2][1] * xa[t + 2][1] + w[3][1] * xa[t + 3][1];
#pragma unroll
                for (int e = 0; e < 4; ++e) { a[e] = siluf_(a[e]); b[e] = siluf_(b[e]); }
                if (j < 4) { float ss = (a[0] * a[0] + a[1] * a[1]) + (a[2] * a[2] + a[3] * a[3]) + (b[0] * b[0] + b[1] * b[1]) + (b[2] * b[2] + b[3] * b[3]);
                    ss += __shfl_xor(ss, 1); ss += __shfl_xor(ss, 2); ss += __shfl_xor(ss, 4); ss += __shfl_xor(ss, 8);
                    const float rs = rsqrtf(ss + RMS_EPS); a = a * rs; b = b * rs; }
                *(u32x4*)(dst + (size_t)(t0 + t) * 3072 + ch) = pg8::pack8(a, b); }
        }
        { const int t = t0 + (F.lane >> 3), h = F.lane & 7; const float* sp = WSP(float, WS_SMALLP) + (size_t)t * 32;
          WSP(float, WS_GBETA)[(size_t)t * 8 + h] = sigmoidf_(sp[8 + h]);
          WSP(float, WS_GG)[(size_t)t * 8 + h] = -__expf(F.in[I_ALOG][h]) * softplusf_(sp[16 + h] + F.in[I_DTB][h]); }
    }
}
constexpr int GP_REG = 0, GP_REGB = 9216, GP_VEC = 73728, GP_VECB = 768, GP_TILE = 79872, GP_TILEB = 17408;
static_assert(GP_TILE + 4 * GP_TILEB <= RING_BYTES, "prep LDS");
__device__ __forceinline__ constexpr int offL(int i) { const int g = (i + 3) >> 2; return 8 * g * (g - 1) + 4 * g * (i - 4 * g + 3); }
__device__ __forceinline__ constexpr int offT(int i) { const int G = i >> 3; return 32 * G * (G + 1) + 8 * (G + 1) * (i - 8 * G); }
struct PrepRegs { u32x4 a[4][4], b[4][4]; };
__device__ __forceinline__ void prep_load(PrepRegs& R, const unsigned char* ws, int u, int tg, int sa, int sb) {
    const int n = u & (NCHUNK - 1), bh = u >> 7, h = bh & 7, b = bh >> 3; const bf16* src = (const bf16*)(ws + WS_PROJ) + ((size_t)b * SEQ + (size_t)n * GCH) * NPROJ + PC_GQKV + h * HD;
#pragma unroll
    for (int i = 0; i < 4; ++i) { const int id = tg + 256 * i, row = id >> 4, cc = id & 15;
#pragma unroll
        for (int tp = 0; tp < 4; ++tp) { const int rr = row - 3 + tp;
            if (n * GCH + rr >= 0) { const int ro = rr * NPROJ + cc * 8; R.a[i][tp] = *(const u32x4*)(src + ro + sa * 1024); R.b[i][tp] = *(const u32x4*)(src + ro + sb * 1024); }
            else { R.a[i][tp] = (u32x4){0u, 0u, 0u, 0u}; R.b[i][tp] = R.a[i][tp]; } } }
}
__device__ __forceinline__ void prep_conv(const u32x4 (&x)[4], const f32x4 (&w)[4][2], bool norm, LAS bf16* dst) {
    f32x4 a = {0.f, 0.f, 0.f, 0.f}, b = a;
#pragma unroll
    for (int tp = 0; tp < 4; ++tp) { f32x4 x0, x1; pg8::unpack8(x[tp], x0, x1); a += w[tp][0] * x0; b += w[tp][1] * x1; }
#pragma unroll
    for (int e = 0; e < 4; ++e) { a[e] = siluf_(a[e]); b[e] = siluf_(b[e]); }
    float ss = (a[0] * a[0] + a[1] * a[1]) + (a[2] * a[2] + a[3] * a[3]) + (b[0] * b[0] + b[1] * b[1]) + (b[2] * b[2] + b[3] * b[3]);
    ss = sum16_dpp(ss);
    if (norm) { const float rs = rsqrtf(ss + RMS_EPS); a = a * rs; b = b * rs; }
    *(LAS u32x4*)dst = pg8::pack8(a, b);
}
__device__ __forceinline__ void prep_write(const PrepRegs& R, LAS bf16* ta, LAS bf16* tb, int tg, const float* cw, int h, int sa, int sb) {
    const int cc = tg & 15;
    { f32x4 w[4][2];
#pragma unroll
      for (int tp = 0; tp < 4; ++tp) { const float* p = cw + tp * 3072 + sa * 1024 + h * HD + cc * 8; w[tp][0] = *(const f32x4*)p; w[tp][1] = *(const f32x4*)(p + 4); }
#pragma unroll
      for (int i = 0; i < 4; ++i) prep_conv(R.a[i], w, sa < 2, ta + ((tg + 256 * i) >> 4) * 136 + cc * 8);
      asm volatile("" ::: "memory"); }
    { f32x4 w[4][2];
#pragma unroll
      for (int tp = 0; tp < 4; ++tp) { const float* p = cw + tp * 3072 + sb * 1024 + h * HD + cc * 8; w[tp][0] = *(const f32x4*)p; w[tp][1] = *(const f32x4*)(p + 4); }
#pragma unroll
      for (int i = 0; i < 4; ++i) prep_conv(R.b[i], w, sb < 2, tb + ((tg + 256 * i) >> 4) * 136 + cc * 8); }
}
__device__ __forceinline__ void p3_gdn_prep(Frame& F, int bid) {
    LAS unsigned char* L0 = F.lds + RING_OFF;
    const int w = F.wave, g = w >> 2, wg = w & 3, tg = F.tid & 255; constexpr float SCQ = 0.08838834764831845f;
    LAS bf16* T0 = (LAS bf16*)(L0 + GP_TILE + 2 * g * GP_TILEB); LAS bf16* Kt = (LAS bf16*)(L0 + GP_TILE + (2 * g + 1) * GP_TILEB);
    { const int u = bid + 256 * w, n = u & (NCHUNK - 1), bh = u >> 7, h = bh & 7, b = bh >> 3; const int ln = F.lane;
        const float* sp = WSP(float, WS_SMALLP) + ((size_t)b * SEQ + (size_t)n * GCH + ln) * 32; float gg = -__expf(F.in[I_ALOG][h]) * softplusf_(sp[16 + h] + F.in[I_DTB][h]); const float bt = sigmoidf_(sp[8 + h]);
#pragma unroll
        for (int o = 1; o < 64; o <<= 1) { const float t = __shfl_up(gg, o); if (ln >= o) gg += t; }
        LAS float* gcv = (LAS float*)(L0 + GP_VEC + w * GP_VECB); gcv[ln] = gg; gcv[64 + ln] = bt; gcv[128 + ln] = __expf(gg); }
    { int tgA; asm volatile("v_mov_b32 %0, %1" : "=v"(tgA) : "v"(tg));
      PrepRegs R; prep_load(R, F.ws, bid + 256 * g, tgA, 0, 1);
      for (int up = 0; up < 4; ++up) { const int ui = 2 * up + g, u = bid + 256 * ui;
        int ln; asm volatile("v_mov_b32 %0, %1" : "=v"(ln) : "v"(F.lane));
        const int c = ln & 31, hi = ln >> 5; const int h = (u >> 7) & 7;
        int tgs; asm volatile("v_mov_b32 %0, %1" : "=v"(tgs) : "v"(tg));
        LAS float* Lr = (LAS float*)(L0 + GP_REG + ui * GP_REGB); const LAS float* gcv = (const LAS float*)(L0 + GP_VEC + ui * GP_VECB); const LAS float* btv = gcv + 64; const LAS float* egv = gcv + 128;
        LAS bf16* Qt = T0;
        prep_write(R, Qt, Kt, tgs, F.in[I_CONVW], h, 0, 1);
        if (up + 1 < 4) prep_load(R, F.ws, u + 512, tgs, 0, 1);
        __syncthreads();
#pragma unroll
        for (int jj = 0; jj < 2; ++jj) { const int job = wg + 4 * jj; if (job < 6) { const int kind = job >= 3, tl = job - 3 * kind, rbi = tl > 0, rbj = tl > 1; const LAS bf16* X = kind ? Qt : Kt;
            f32x16 acc = {};
#pragma unroll
            for (int s = 0; s < 8; ++s) { const bf16x8 a = *(const LAS bf16x8*)(X + (32 * rbi + c) * 136 + 16 * s + 8 * hi), bb = *(const LAS bf16x8*)(Kt + (32 * rbj + c) * 136 + 16 * s + 8 * hi);
                acc = __builtin_amdgcn_mfma_f32_32x32x16_bf16(a, bb, acc, 0, 0, 0); }
            const int j = 32 * rbj + c; const float gj = gcv[j];
#pragma unroll
            for (int r = 0; r < 16; ++r) { const int i = 32 * rbi + crow(r, hi); const float dec = __expf(fminf(gcv[i] - gj, 0.f));
                if (kind == 0) { const int g4 = (i + 3) >> 2; if (j < 4 * g4) Lr[8 * g4 * (g4 - 1) + 4 * g4 * (i - 4 * g4 + 3) + j] = (i > j) ? btv[i] * acc[r] * dec : 0.f; }
                else WSP(bf16, WS_GATT)[(size_t)u * 4096 + i * 64 + j] = f2bf((i >= j) ? acc[r] * SCQ * dec : 0.f); } } }
        if (wg == 2) { for (int i = ln; i < 32 * 32; i += 64) WSP(bf16, WS_GATT)[(size_t)u * 4096 + (i >> 5) * 64 + 32 + (i & 31)] = 0; }
        if (wg == 3 && ln == 0) WSP(float, WS_GGL)[u] = egv[63];
        { const float gl = gcv[63];
#pragma unroll
          for (int i2 = 0; i2 < 4; ++i2) { const int id = tgs + 256 * i2, row = id >> 4, cc = id & 15; f32x4 a, bq; pg8::unpack8(*(const LAS u32x4*)(Qt + row * 136 + cc * 8), a, bq); const float sc = SCQ * egv[row];
              *(u32x4*)(WSP(bf16, WS_GQD) + (size_t)u * 8192 + row * 128 + cc * 8) = pg8::pack8(a * sc, bq * sc); }
#pragma unroll
          for (int i2 = 0; i2 < 4; ++i2) { const int id = tgs + 256 * i2, d = id >> 3, i0 = (id & 7) * 8; float v[8];
#pragma unroll
              for (int e = 0; e < 8; ++e) v[e] = bf2f(Kt[(i0 + e) * 136 + d]) * __expf(gl - gcv[i0 + e]);
              u32x4 o; o.x = cvt_pk_bf16(v[0], v[1]); o.y = cvt_pk_bf16(v[2], v[3]); o.z = cvt_pk_bf16(v[4], v[5]); o.w = cvt_pk_bf16(v[6], v[7]);
              *(u32x4*)(WSP(bf16, WS_GKDT) + (size_t)u * 8192 + d * 64 + i0) = o; } }
        __syncthreads();
      } }
    { int cl; asm volatile("v_mov_b32 %0, %1" : "=v"(cl) : "v"(F.lane)); int vz; asm volatile("v_mov_b32 %0, 0" : "=v"(vz));
        const LAS float* Lz = (const LAS float*)(L0 + GP_REG + w * GP_REGB) + vz; const LAS float* gcv = (const LAS float*)(L0 + GP_VEC + w * GP_VECB);
        float t[64];
#pragma unroll
        for (int i = 0; i < 64; ++i) { float s0 = (i == cl) ? 1.f : 0.f, s1 = 0.f, s2 = 0.f, s3 = 0.f;
#pragma unroll
            for (int j4 = 0; j4 < (i + 3) / 4; ++j4) { const f32x4 l = *(const LAS f32x4*)(Lz + offL(i > 0 ? i : 1) + 4 * j4);
                if (4 * j4 + 0 < i) s0 -= l[0] * t[4 * j4 + 0]; if (4 * j4 + 1 < i) s1 -= l[1] * t[4 * j4 + 1]; if (4 * j4 + 2 < i) s2 -= l[2] * t[4 * j4 + 2]; if (4 * j4 + 3 < i) s3 -= l[3] * t[4 * j4 + 3]; }
            t[i] = (s0 + s1) + (s2 + s3); asm volatile("" : "+v"(t[i]) : : "memory"); }
        const float bu = gcv[64 + cl], bw = bu * gcv[128 + cl];
        LAS bf16* Tu = (LAS bf16*)(L0 + GP_REG + w * GP_REGB); LAS bf16* Tw = Tu + 2304;
#pragma unroll
        for (int i = 0; i < 64; ++i) if (cl < 8 * ((i >> 3) + 1)) { Tu[offT(i) + cl] = f2bf(t[i] * bu); Tw[offT(i) + cl] = f2bf(t[i] * bw); }
    }
    __syncthreads();
    { int tgC; asm volatile("v_mov_b32 %0, %1" : "=v"(tgC) : "v"(tg));
      PrepRegs R; prep_load(R, F.ws, bid + 256 * g, tgC, 2, 1);
      for (int up = 0; up < 4; ++up) { const int ui = 2 * up + g, u = bid + 256 * ui;
        int ln; asm volatile("v_mov_b32 %0, %1" : "=v"(ln) : "v"(F.lane));
        const int c = ln & 31, hi = ln >> 5;
        int tgs; asm volatile("v_mov_b32 %0, %1" : "=v"(tgs) : "v"(tg));
        LAS bf16* Vt = T0;
        prep_write(R, Vt, Kt, tgs, F.in[I_CONVW], (u >> 7) & 7, 2, 1);
        if (up + 1 < 4) prep_load(R, F.ws, u + 512, tgs, 2, 1);
        __syncthreads();
        const LAS bf16* Tb = (const LAS bf16*)(L0 + GP_REG + ui * GP_REGB);
#pragma unroll 1
        for (int jj = 0; jj < 4; ++jj) { const int job = 4 * wg + jj, mat = job >> 3, rbi = (job >> 2) & 1, cb = job & 3; const LAS bf16* TA = Tb + mat * 2304; const LAS bf16* X = mat ? Kt : Vt;
            const int i = 32 * rbi + c, G = i >> 3, to = 32 * G * (G + 1) + 8 * (G + 1) * (i - 8 * G);
            f32x16 acc = {};
#pragma unroll
            for (int s = 0; s < 4; ++s) { if (s >= 2 && rbi == 0) continue;
                const int k0 = 16 * s + 8 * hi; bf16x8 a = *(const LAS bf16x8*)(TA + to + (k0 <= i ? k0 : 0)); if (k0 > i) a = (bf16x8){0, 0, 0, 0, 0, 0, 0, 0};
                bf16x8 bb;
#pragma unroll
                for (int e = 0; e < 8; ++e) bb[e] = (short)X[(16 * s + 8 * hi + e) * 136 + 32 * cb + c];
                acc = __builtin_amdgcn_mfma_f32_32x32x16_bf16(a, bb, acc, 0, 0, 0); }
            if (mat) { bf16* o = WSP(bf16, WS_GW) + (size_t)u * 8192 + 32 * cb + c;
#pragma unroll
                for (int r = 0; r < 16; ++r) o[(32 * rbi + crow(r, hi)) * 128] = f2bf(acc[r]); }
            else { bf16* o = WSP(bf16, WS_GU) + (size_t)u * 8192 + (32 * cb + c) * 64 + 32 * rbi + 4 * hi;
#pragma unroll
                for (int gq = 0; gq < 4; ++gq) { u32x2 v; v.x = cvt_pk_bf16(acc[4 * gq], acc[4 * gq + 1]); v.y = cvt_pk_bf16(acc[4 * gq + 2], acc[4 * gq + 3]); *(u32x2*)(o + 8 * gq) = v; } } }
        __syncthreads();
      } }
}
constexpr int SB_W = 0, SB_QD = 16384, SB_KDT = 32768, SB_AT = 49152, SB_SZ = 57344, SB_PW = 2 * SB_SZ, SB_PWB = 6656;
static_assert(SB_PW + 4 * SB_PWB <= RING_BYTES, "scan LDS");
struct ScanRegs { u32x4 w[4], qd[4], kd[4], at[2]; };
__device__ __forceinline__ void scan_load(ScanRegs& R, const unsigned char* ws, size_t u, int lt) {
    const bf16* gw_ = (const bf16*)(ws + WS_GW) + u * 8192; const bf16* gq = (const bf16*)(ws + WS_GQD) + u * 8192; const bf16* gk = (const bf16*)(ws + WS_GKDT) + u * 8192; const bf16* ga = (const bf16*)(ws + WS_GATT) + u * 4096;
#pragma unroll
    for (int i = 0; i < 4; ++i) { const int id = lt + 256 * i; R.w[i] = *(const u32x4*)(gw_ + id * 8); R.qd[i] = *(const u32x4*)(gq + id * 8); R.kd[i] = *(const u32x4*)(gk + id * 8); }
#pragma unroll
    for (int i = 0; i < 2; ++i) { const int id = lt + 256 * i; R.at[i] = *(const u32x4*)(ga + id * 8); }
}
__device__ __forceinline__ void scan_write(const ScanRegs& R, LAS unsigned char* buf, int lt) {
#pragma unroll
    for (int i = 0; i < 4; ++i) { const int id = lt + 256 * i; { const int row = id >> 4, cc = id & 15, o = row * 256 + ((cc ^ (row & 15)) << 4); *(LAS u32x4*)(buf + SB_W + o) = R.w[i]; *(LAS u32x4*)(buf + SB_QD + o) = R.qd[i]; }
        { const int row = id >> 3, cc = id & 7; *(LAS u32x4*)(buf + SB_KDT + row * 128 + ((cc ^ ((row >> 1) & 7)) << 4)) = R.kd[i]; } }
#pragma unroll
    for (int i = 0; i < 2; ++i) { const int id = lt + 256 * i, row = id >> 3, cc = id & 7; *(LAS u32x4*)(buf + SB_AT + row * 128 + ((cc ^ ((row >> 1) & 7)) << 4)) = R.at[i]; }
}
#define SCAN_BAR() do { asm volatile("s_waitcnt lgkmcnt(0)" ::: "memory"); __builtin_amdgcn_s_barrier(); asm volatile("" ::: "memory"); } while (0)
__device__ __forceinline__ void scan_compute(LAS unsigned char* buf, LAS bf16* SbT, LAS bf16* VNT, f32x4 (&S)[8], const u32x2 (&uu)[4], float gl, float* go, int c, int q) {
    int a256[4], a128[2];
#pragma unroll
    for (int ks = 0; ks < 4; ++ks) a256[ks] = c * 256 + (((4 * ks + q) ^ c) << 4);
#pragma unroll
    for (int ks = 0; ks < 2; ++ks) a128[ks] = c * 128 + (((4 * ks + q) ^ ((c >> 1) & 7)) << 4);
#pragma unroll
    for (int rt = 0; rt < 8; ++rt) { u32x2 o; o.x = cvt_pk_bf16(S[rt][0], S[rt][1]); o.y = cvt_pk_bf16(S[rt][2], S[rt][3]); *(LAS u32x2*)(SbT + c * 136 + 16 * rt + 4 * q) = o; }
    bf16x8 sb[4];
#pragma unroll
    for (int ks = 0; ks < 4; ++ks) sb[ks] = *(const LAS bf16x8*)(SbT + c * 136 + 32 * ks + 8 * q);
#pragma unroll
    for (int rt = 0; rt < 4; ++rt) { f32x4 p = {0.f, 0.f, 0.f, 0.f};
#pragma unroll
        for (int ks = 0; ks < 4; ++ks) p = __builtin_amdgcn_mfma_f32_16x16x32_bf16(*(const LAS bf16x8*)(buf + SB_W + rt * 4096 + a256[ks]), sb[ks], p, 0, 0, 0);
        u32x2 o; o.x = cvt_pk_bf16(bf_lo(uu[rt].x) - p[0], bf_hi(uu[rt].x) - p[1]); o.y = cvt_pk_bf16(bf_lo(uu[rt].y) - p[2], bf_hi(uu[rt].y) - p[3]); *(LAS u32x2*)(VNT + c * 72 + 16 * rt + 4 * q) = o; }
    bf16x8 vb[2];
#pragma unroll
    for (int ks = 0; ks < 2; ++ks) vb[ks] = *(const LAS bf16x8*)(VNT + c * 72 + 32 * ks + 8 * q);
#pragma unroll
    for (int rt = 0; rt < 4; ++rt) { f32x4 p = {0.f, 0.f, 0.f, 0.f};
#pragma unroll
        for (int ks = 0; ks < 4; ++ks) p = __builtin_amdgcn_mfma_f32_16x16x32_bf16(*(const LAS bf16x8*)(buf + SB_QD + rt * 4096 + a256[ks]), sb[ks], p, 0, 0, 0);
#pragma unroll
        for (int ks = 0; ks < 2; ++ks) p = __builtin_amdgcn_mfma_f32_16x16x32_bf16(*(const LAS bf16x8*)(buf + SB_AT + rt * 2048 + a128[ks]), vb[ks], p, 0, 0, 0);
#pragma unroll
        for (int e = 0; e < 4; ++e) go[(size_t)(16 * rt + 4 * q + e) * FW] = p[e]; }
#pragma unroll
    for (int rt = 0; rt < 8; ++rt) { f32x4 p = S[rt] * gl;
#pragma unroll
        for (int ks = 0; ks < 2; ++ks) p = __builtin_amdgcn_mfma_f32_16x16x32_bf16(*(const LAS bf16x8*)(buf + SB_KDT + rt * 2048 + a128[ks]), vb[ks], p, 0, 0, 0);
        S[rt] = p; }
}
__device__ __forceinline__ void p4_gdn_scan_item(Frame& F, int item) {
    LAS unsigned char* L0 = F.lds + RING_OFF; LAS unsigned char* buf0 = L0; LAS unsigned char* buf1 = L0 + SB_SZ;
    const int w = F.wave, bh = item >> 1, half = item & 1, h = bh & 7, b = bh >> 3; const size_t u0 = (size_t)bh * NCHUNK;
    int tid_; asm volatile("v_mov_b32 %0, %1" : "=v"(tid_) : "v"(F.tid));
    if (w >= 4) {
        const int lt = tid_ - 256; ScanRegs A, B;
        scan_load(A, F.ws, u0, lt); scan_load(B, F.ws, u0 + 1, lt);
        scan_write(A, buf0, lt); scan_load(A, F.ws, u0 + 2, lt);
        SCAN_BAR();
        for (int n = 0; n < NCHUNK; n += 2) {
            scan_write(B, buf1, lt); scan_load(B, F.ws, u0 + (n + 3 < NCHUNK ? n + 3 : NCHUNK - 1), lt);
            SCAN_BAR();
            scan_write(A, buf0, lt); scan_load(A, F.ws, u0 + (n + 4 < NCHUNK ? n + 4 : NCHUNK - 1), lt);
            SCAN_BAR();
        }
    } else {
        const int c = tid_ & 15, q = (tid_ & 63) >> 4, col = 64 * half + 16 * w + c;
        LAS bf16* SbT = (LAS bf16*)(L0 + SB_PW + w * SB_PWB); LAS bf16* VNT = SbT + 16 * 136;
        f32x4 S[8];
#pragma unroll
        for (int i = 0; i < 8; ++i) S[i] = (f32x4){0.f, 0.f, 0.f, 0.f};
        const bf16* gu = WSP(bf16, WS_GU) + u0 * 8192 + col * 64 + 4 * q; const float* ggl = WSP(float, WS_GGL) + u0;
        float* go = WSP(float, WS_GO) + ((size_t)b * SEQ) * FW + h * HD + col;
        u32x2 ua[4], ub[4]; float gla, glb;
#pragma unroll
        for (int rt = 0; rt < 4; ++rt) ua[rt] = *(const u32x2*)(gu + 16 * rt);
        gla = ggl[0];
        SCAN_BAR();
        for (int n = 0; n < NCHUNK; n += 2) {
            { const size_t un = (size_t)(n + 1) * 8192;
#pragma unroll
              for (int rt = 0; rt < 4; ++rt) ub[rt] = *(const u32x2*)(gu + un + 16 * rt);
              glb = ggl[n + 1]; }
            scan_compute(buf0, SbT, VNT, S, ua, gla, go + (size_t)n * GCH * FW, c, q);
            SCAN_BAR();
            { const int n2 = n + 2 < NCHUNK ? n + 2 : NCHUNK - 1; const size_t un = (size_t)n2 * 8192;
#pragma unroll
              for (int rt = 0; rt < 4; ++rt) ua[rt] = *(const u32x2*)(gu + un + 16 * rt);
              gla = ggl[n2]; }
            scan_compute(buf1, SbT, VNT, S, ub, glb, go + (size_t)(n + 1) * GCH * FW, c, q);
            SCAN_BAR();
        }
    }
}
struct P5Buf { f32x4 a[2], b[2]; u32x4 z[2]; };
__device__ __forceinline__ void p5_load(P5Buf& B, const Frame& F, int m) {
#pragma unroll
    for (int j = 0; j < 2; ++j) { const int col = 8 * F.lane + 512 * j; const float* op = WSP(float, WS_GO) + (size_t)m * FW + col;
        B.a[j] = *(const f32x4*)op; B.b[j] = *(const f32x4*)(op + 4); B.z[j] = *(const u32x4*)(WSP(bf16, WS_PROJ) + (size_t)m * NPROJ + PC_GZ + col); }
}
__device__ __forceinline__ void p5_row(const P5Buf& B, const Frame& F, int m) {
    const float* nw = F.in[I_ONW];
#pragma unroll
    for (int j = 0; j < 2; ++j) { const int col = 8 * F.lane + 512 * j; f32x4 a = B.a[j], b = B.b[j], z0, z1; pg8::unpack8(B.z[j], z0, z1);
        float ss = (a[0] * a[0] + a[1] * a[1]) + (a[2] * a[2] + a[3] * a[3]) + (b[0] * b[0] + b[1] * b[1]) + (b[2] * b[2] + b[3] * b[3]);
        ss = sum16_dpp(ss);
        const float rs = rsqrtf(ss * (1.f / HD) + RMS_EPS); const f32x4 w0 = *(const f32x4*)(nw + (col & 127)), w1 = *(const f32x4*)(nw + (col & 127) + 4);
#pragma unroll
        for (int e = 0; e < 4; ++e) { a[e] = a[e] * rs * w0[e] * siluf_(z0[e]); b[e] = b[e] * rs * w1[e] * siluf_(z1[e]); }
        *(u32x4*)(WSP(bf16, WS_YF) + (size_t)m * DM + FW + col) = pg8::pack8(a, b); }
}
__device__ __forceinline__ void p5_gdn_outnorm(Frame& F) {
    const int gw = blockIdx.x * NWAVES + F.wave, NGW = F.G * NWAVES;
    P5Buf A, B; if (gw < T) p5_load(A, F, gw);
#pragma unroll 1
    for (int m = gw; m < T; m += 2 * NGW) { if (m + NGW < T) p5_load(B, F, m + NGW); p5_row(A, F, m); if (m + 2 * NGW < T) p5_load(A, F, m + 2 * NGW); if (m + NGW < T) p5_row(B, F, m + NGW); }
}
#endif
#if HAVE_MOE
struct PostRouter { const float* br; unsigned* cnt; int* toke; float* tokw; int* tokp; int lane, wave;
    __device__ __forceinline__ void operator()(int row0, const LAS float* fin) const {
        if (wave != 0) return;
        const int t = row0 + lane; float v[32];
#pragma unroll
        for (int e = 0; e < 32; ++e) v[e] = fin[lane * 33 + e] + br[e];
        int be[4]; float bv[4];
#pragma unroll
        for (int k = 0; k < 4; ++k) { float best = v[0]; int bi = 0;
#pragma unroll
            for (int e = 1; e < 32; ++e) if (v[e] > best) { best = v[e]; bi = e; }
            be[k] = bi; bv[k] = best;
#pragma unroll
            for (int e = 0; e < 32; ++e) v[e] = (e == bi) ? -__builtin_inff() : v[e]; }
        const float e1 = __expf(bv[1] - bv[0]), e2 = __expf(bv[2] - bv[0]), e3 = __expf(bv[3] - bv[0]), inv = 1.f / (1.f + e1 + e2 + e3);
        const float ww[4] = {inv, e1 * inv, e2 * inv, e3 * inv};
#pragma unroll
        for (int k = 0; k < 4; ++k) { const unsigned pos = __hip_atomic_fetch_add(cnt + 64 * be[k], 1u, __ATOMIC_RELAXED, __HIP_MEMORY_SCOPE_AGENT);
            toke[(size_t)t * 4 + k] = be[k]; tokw[(size_t)t * 4 + k] = ww[k]; tokp[(size_t)t * 4 + k] = (int)pos; }
    }
};
__device__ __forceinline__ void p8_router(Frame& F) {
    { const float* x = F.in[I_X]; const bf16* dl = WSP(bf16, WS_TMP); const f32x4* nw = (const f32x4*)F.in[I_N2W] + F.lane; bf16* xn = WSP(bf16, WS_XN2);
      for (int tile = blockIdx.x; tile < T / 64; tile += F.G)
          for (int rr = 0; rr < 8; ++rr) { const int m = tile * 64 + F.wave * 8 + rr;
              const f32x4* xr = (const f32x4*)(x + (size_t)m * DM) + F.lane; const u32x2* dr = (const u32x2*)(dl + (size_t)m * DM) + F.lane; f32x4 v[8]; float ss = 0.f;
#pragma unroll
              for (int j = 0; j < 8; ++j) { const u32x2 d = dr[64 * j]; v[j] = xr[64 * j] + (f32x4){bf_lo(d.x), bf_hi(d.x), bf_lo(d.y), bf_hi(d.y)};
                  ss += (v[j][0] * v[j][0] + v[j][1] * v[j][1]) + (v[j][2] * v[j][2] + v[j][3] * v[j][3]);
#if X1_BF16
                  { u32x2 o; o.x = cvt_pk_bf16(v[j][0], v[j][1]); o.y = cvt_pk_bf16(v[j][2], v[j][3]); ((u32x2*)(WSP(bf16, WS_TMP) + (size_t)m * DM) + F.lane)[64 * j] = o; }
#endif
                  }
              const float rs = rsqrtf(wave_sum(ss) * (1.f / DM) + RMS_EPS);
              u32x2* o8 = (u32x2*)(xn + (size_t)m * DM) + F.lane;
#pragma unroll
              for (int j = 0; j < 8; ++j) { const f32x4 w = nw[64 * j]; u32x2 o; o.x = cvt_pk_bf16(v[j][0] * rs * w[0], v[j][1] * rs * w[1]); o.y = cvt_pk_bf16(v[j][2] * rs * w[2], v[j][3] * rs * w[3]); o8[64 * j] = o;
#if MOE_GATHER
                  ((unsigned*)(WSP(unsigned char, WS_XN8) + (size_t)m * DM) + F.lane)[64 * j] = pg8::pk4_fp8(bf_lo(o.x), bf_hi(o.x), bf_lo(o.y), bf_hi(o.y));
#endif
              }
          } }
    __threadfence_block(); VM_WAIT(); __syncthreads();
    PostRouter P{F.in[I_BR], (unsigned*)(F.ctl + CW_CNT), WSP(int, WS_TOKE), WSP(float, WS_TOKW), WSP(int, WS_TOKP), F.lane, F.wave}; skinny32(F, WSP(bf16, WS_XN2), WSP(bf16, WS_WRT), P);
}
__device__ __forceinline__ int moe_tables(Frame& F, LAS int* base, LAS int* tile_e) {
    LAS int* ntot = base + 32;
    if (F.wave == 0) { const int e = F.lane & 31; const int cnt = (int)__hip_atomic_load((unsigned*)(F.ctl + CW_CNT + 64 * e), __ATOMIC_RELAXED, __HIP_MEMORY_SCOPE_AGENT); const int nt = (cnt + 255) >> 8;
        int incl = nt;
#pragma unroll
        for (int o = 1; o < 32; o <<= 1) { const int t = __shfl_up(incl, o); if ((F.lane & 31) >= o) incl += t; }
        const int off = incl - nt;
        if (F.lane < 32) { base[e] = off * 256; for (int i = 0; i < nt; ++i) tile_e[off + i] = e; if (e == 31) ntot[0] = incl; } }
    LDS_WAIT(); __syncthreads();
    return __builtin_amdgcn_readfirstlane(ntot[0]);
}
__device__ __forceinline__ void p9_gather(Frame& F) {
    LAS int* base = (LAS int*)(F.lds + TAB_OFF); LAS int* tile_e = base + 64;
    (void)moe_tables(F, base, tile_e);
#if MOE_GATHER
    { unsigned short* tos = WSP(unsigned short, WS_TOS);
      for (int a = (int)blockIdx.x * (NWAVES * 64) + F.tid; a < T * TOPK; a += F.G * NWAVES * 64) { const int e = WSP(int, WS_TOKE)[a], slot = base[e] + WSP(int, WS_TOKP)[a]; tos[slot] = (unsigned short)(a >> 2); WSP(int, WS_TOKP)[a] = slot; }
      for (int e = (int)blockIdx.x; e < NE; e += F.G) { const int cnt = (int)__hip_atomic_load((unsigned*)(F.ctl + CW_CNT + 64 * e), __ATOMIC_RELAXED, __HIP_MEMORY_SCOPE_AGENT), end = base[e] + (((cnt + 255) >> 8) << 8);
          for (int s = base[e] + cnt + F.tid; s < end; s += NWAVES * 64) tos[s] = 0; }
      return; }
#endif
    const int gw = blockIdx.x * NWAVES + F.wave, NGW = F.G * NWAVES;
    for (int m = gw; m < T; m += NGW) {
        const u32x4* src = (const u32x4*)(WSP(bf16, WS_XN2) + (size_t)m * DM) + F.lane; u32x4 v[4];
#pragma unroll
        for (int j = 0; j < 4; ++j) v[j] = src[64 * j];
#if MOE_F8_GU
        u32x2 v8[4];
#pragma unroll
        for (int j = 0; j < 4; ++j) { f32x4 a, b; pg8::unpack8(v[j], a, b); v8[j].x = pg8::pk4_fp8(a[0], a[1], a[2], a[3]); v8[j].y = pg8::pk4_fp8(b[0], b[1], b[2], b[3]); }
#endif
#pragma unroll
        for (int k = 0; k < 4; ++k) { const int e = WSP(int, WS_TOKE)[(size_t)m * 4 + k], pos = WSP(int, WS_TOKP)[(size_t)m * 4 + k], slot = base[e] + pos;
#if MOE_F8_GU
            u32x2* d = (u32x2*)(WSP(unsigned char, WS_XS) + (size_t)slot * DM) + F.lane;
#pragma unroll
            for (int j = 0; j < 4; ++j) d[64 * j] = v8[j];
#else
            u32x4* d = (u32x4*)(WSP(bf16, WS_XS) + (size_t)slot * DM) + F.lane;
#pragma unroll
            for (int j = 0; j < 4; ++j) d[64 * j] = v[j];
#endif
            if (F.lane == 0) WSP(int, WS_TOKP)[(size_t)m * 4 + k] = slot; }
    }
}
__device__ __forceinline__ void p10_gateup(Frame& F) {
    LAS int* base = (LAS int*)(F.lds + TAB_OFF); LAS int* tile_e = base + 64;
    const int NT = moe_tables(F, base, tile_e);
    pg8::MoeOrder S; S.init(NT, 16, F.G, (int)blockIdx.x); S.tile_e = tile_e; S.nrows_e = 4096;
    pg8::EpiSwiglu<MOE_F8_DN != 0> E{WSP(void, WS_ACT), DFF, WSP(float, WS_BGU), MOE_F8_GU ? pg8::W8_INV : 1.f};
#if MOE_GATHER
    LAS unsigned short* TL = (LAS unsigned short*)(F.lds + TLD_OFF);
    { pg8::Unit u; for (int ui = 0; S.next(ui, u); ++ui) if (F.tid < 256) TL[ui * 256 + F.tid] = WSP(unsigned short, WS_TOS)[u.pm * 256 + F.tid]; }
    LDS_WAIT(); __syncthreads();
    pg8::Gemm g{WSP(bf16, WS_XN8), WSP(bf16, WS_WGUT), DM / 2, TL};
    pg8::gemm_phase<pg8::EpiSwiglu<MOE_F8_DN != 0>, pg8::MoeOrder, true, true, true, pg8::NoMid, true>(F.lds + RING_OFF, g, S, E);
#else
    pg8::Gemm g{WSP(bf16, WS_XS), WSP(bf16, WS_WGUT), MOE_F8_GU ? DM / 2 : DM};
    pg8::gemm_phase<pg8::EpiSwiglu<MOE_F8_DN != 0>, pg8::MoeOrder, true, true, MOE_F8_GU != 0>(F.lds + RING_OFF, g, S, E);
#endif
}
__device__ __forceinline__ void p11_down(Frame& F) {
    LAS int* base = (LAS int*)(F.lds + TAB_OFF); LAS int* tile_e = base + 64;
    const int NT = moe_tables(F, base, tile_e);
    pg8::MoeOrder S; S.init(NT, 8, F.G, (int)blockIdx.x); S.tile_e = tile_e; S.nrows_e = DM;
#if YB_F8
    pg8::EpiF8 E{WSP(unsigned char, WS_YB), DM, F.in[I_BD], DM, MOE_F8_DN ? pg8::W8_INV : 1.f};
    pg8::Gemm g{WSP(bf16, WS_ACT), WSP(bf16, WS_WDT), MOE_F8_DN ? DFF / 2 : DFF};
    pg8::gemm_phase<pg8::EpiF8, pg8::MoeOrder, true, true, MOE_F8_DN != 0>(F.lds + RING_OFF, g, S, E);
#else
    pg8::EpiBf16 E{WSP(bf16, WS_YB), DM, F.in[I_BD], DM, MOE_F8_DN ? pg8::W8_INV : 1.f};
    pg8::Gemm g{WSP(bf16, WS_ACT), WSP(bf16, WS_WDT), MOE_F8_DN ? DFF / 2 : DFF};
    pg8::gemm_phase<pg8::EpiBf16, pg8::MoeOrder, true, true, MOE_F8_DN != 0>(F.lds + RING_OFF, g, S, E);
#endif
}
struct P12Buf { f32x4 xa[4], xb[4]; u32x4 d[4]; u32x2 y[4][4]; };
__device__ __forceinline__ void p12_load(P12Buf& B, const Frame& F, int m, const int (&sl)[4]) {
    const float* xrow = F.in[I_X] + (size_t)m * DM + 8 * F.lane; const bf16* drow = WSP(bf16, WS_TMP) + (size_t)m * DM + 8 * F.lane;
#pragma unroll
    for (int j = 0; j < 4; ++j) { B.xa[j] = *(const f32x4*)(xrow + 512 * j); B.xb[j] = *(const f32x4*)(xrow + 512 * j + 4); B.d[j] = *(const u32x4*)(drow + 512 * j);
#pragma unroll
        for (int k = 0; k < 4; ++k) B.y[j][k] = *(const u32x2*)(WSP(unsigned char, WS_YB) + (size_t)sl[k] * DM + 8 * F.lane + 512 * j); }
}
__device__ __forceinline__ void p12_store(const P12Buf& B, const Frame& F, int m, const float (&ww)[4]) {
    float* orow = F.out + (size_t)m * DM + 8 * F.lane;
#pragma unroll
    for (int j = 0; j < 4; ++j) { f32x4 a = B.xa[j], b = B.xb[j], d0, d1; pg8::unpack8(B.d[j], d0, d1); a += d0; b += d1;
#pragma unroll
        for (int k = 0; k < 4; ++k) { const u32x2 yw = B.y[j][k];
            const f32x2 p0 = __builtin_amdgcn_cvt_pk_f32_fp8((int)yw.x, false), p1 = __builtin_amdgcn_cvt_pk_f32_fp8((int)yw.x, true), p2 = __builtin_amdgcn_cvt_pk_f32_fp8((int)yw.y, false), p3 = __builtin_amdgcn_cvt_pk_f32_fp8((int)yw.y, true);
            a += (f32x4){p0[0], p0[1], p1[0], p1[1]} * ww[k]; b += (f32x4){p2[0], p2[1], p3[0], p3[1]} * ww[k]; }
        *(f32x4*)(orow + 512 * j) = a; *(f32x4*)(orow + 512 * j + 4) = b; }
}
__device__ __forceinline__ void p12_combine(Frame& F) {
    static_assert(YB_F8 != 0, "the combine phase reads fp8 YB rows");
    const int gw = blockIdx.x * NWAVES + F.wave, NGW = F.G * NWAVES;
    constexpr int TS_ = 1;
    for (int m0 = gw * 8; m0 < T; m0 += 8 * NGW) {
        int slv = 0; float wwv = 0.f;
        { const int i = F.lane >> 2, m = m0 + i * TS_; if (F.lane < 32 && m < T) { slv = WSP(int, WS_TOKP)[(size_t)m * 4 + (F.lane & 3)]; wwv = WSP(float, WS_TOKW)[(size_t)m * 4 + (F.lane & 3)]; } }
        P12Buf A, B; int sl[4]; float wa[4], wb[4];
#define P12_META(i, w) do { _Pragma("unroll") for (int k = 0; k < 4; ++k) { sl[k] = __builtin_amdgcn_readlane(slv, 4 * (i) + k); w[k] = __builtin_bit_cast(float, __builtin_amdgcn_readlane(__builtin_bit_cast(int, wwv), 4 * (i) + k)); } } while (0)
        P12_META(0, wa); p12_load(A, F, m0, sl);
#pragma unroll 1
        for (int i = 0; i < 8; i += 2) {
            const int ma = m0 + i * TS_, mb = ma + TS_, mc = mb + TS_;
            if (mb < T) { P12_META(i + 1, wb); p12_load(B, F, mb, sl); }
            p12_store(A, F, ma, wa);
            if (mb >= T) break;
            if (i + 2 < 8 && mc < T) { P12_META(i + 2, wa); p12_load(A, F, mc, sl); }
            p12_store(B, F, mb, wb);
            if (mc >= T) break;
        }
#undef P12_META
    }
}
#endif
struct Args { const float* in[20]; float* out; unsigned char* ws; int ph_lo, ph_hi, li, pad; };
__global__ void __launch_bounds__(NWAVES * 64, 2) fwd_kernel(Args args) {
    extern __shared__ __attribute__((aligned(16))) unsigned char lds[];
    Frame F;
    F.lds = (LAS unsigned char*)lds;
    F.MISC = (volatile LAS unsigned*)(F.lds + MISC_OFF);
    F.tid = threadIdx.x; F.lane = F.tid & 63; F.wave = __builtin_amdgcn_readfirstlane(F.tid >> 6);
    F.G = gridDim.x; F.ws = args.ws; F.ctl = (gu32*)(args.ws + WS_CTL); F.out = args.out;
#pragma unroll
    for (int i = 0; i < 20; ++i) F.in[i] = args.in[i];
    for (int u = F.tid; u < (LDS_BYTES - LDSCTL_OFF) / 4; u += NWAVES * 64) ((LAS unsigned*)(F.lds + LDSCTL_OFF))[u] = 0u;
    __syncthreads();
    const int lo = args.ph_lo, hi = args.ph_hi;
    XcdBarrier bar; bar.bar = (unsigned*)(F.ctl + CW_BAR) + (args.li % 3) * XCD_BAR_WORDS; bar.x = 0; bar.st = nullptr;
    if (hi - lo > 1) bar = xcd_barrier_post((unsigned*)(F.ctl + CW_BAR) + (args.li % 3) * XCD_BAR_WORDS, F.MISC + 8);
#define IN(k) (lo <= (k) && (k) < hi)
#define SEAM(k) do { if (IN(k) && IN((k) + 1)) xcd_barrier(bar); } while (0)
    using namespace pg8;
    PG8_LAS unsigned char* ring = F.lds + RING_OFF;

    if (IN(0)) { p0_prologue(F); }
    SEAM(0);
    if (IN(1)) {
        { PostSmall P{WSP(float, WS_SMALLP), F.tid, F.in[I_BFF], (float*)(F.ctl + CW_TS)}; skinny32(F, WSP(bf16, WS_H1), WSP(bf16, WS_WST), P); }
#if GATES_F8
        { Gemm g{WSP(bf16, WS_H1), WSP(bf16, WS_WINT), DM}; DenseOrder S; S.init(T / 256, 7168 / 256, F.G, (int)blockIdx.x);
          EpiProj E{WSP(bf16, WS_PROJ), WSP(bf16, WS_QN), WSP(bf16, WS_KN), F.in[I_QNW], F.in[I_KNW], (PG8_LAS float*)(ring + 3 * HTB), WSP(bf16, WS_VN)};
          gemm_phase<EpiProj, DenseOrder, true, true>(ring, g, S, E); }
        { Gemm g{WSP(bf16, WS_H8), WSP(bf16, WS_WIN8), DM / 2}; DenseOrder S; S.init(T / 256, 4096 / 256, F.G, (int)blockIdx.x);
#if GATES_SIG == 3
          EpiSigRS E{WSP(bf16, WS_PROJ) + PC_GA, WSP(bf16, WS_PROJ) + PC_GB, W8_INV};
          gemm_phase<EpiSigRS, DenseOrder, true, true, true>(ring, g, S, E); }
#elif GATES_SIG
          EpiSig E{WSP(bf16, WS_PROJ) + PC_GA, NPROJ, W8_INV};
          gemm_phase<EpiSig, DenseOrder, true, true, true>(ring, g, S, E); }
#else
          EpiBf16 E{WSP(bf16, WS_PROJ) + PC_GA, NPROJ, nullptr, 0, W8_INV};
          gemm_phase<EpiBf16, DenseOrder, true, true, true>(ring, g, S, E); }
#endif
#else
        { Gemm g{WSP(bf16, WS_H1), WSP(bf16, WS_WINT), DM}; DenseOrder S; S.init(T / 256, NPROJ / 256, F.G, (int)blockIdx.x);
          EpiBf16 E{WSP(bf16, WS_PROJ), NPROJ, nullptr, 0, 1.f};
          gemm_phase<EpiBf16, DenseOrder, true, true>(ring, g, S, E); }
#endif
    }
    SEAM(1);
    if (IN(2)) {
        p2_cb_tile(F, (int)blockIdx.x);
        p3_gdn_prep(F, (int)blockIdx.x);
    }
    SEAM(2);
    if (IN(4)) {
        const int qw = CW_Q + 2048 * args.li;
#if CONV_IN_P4
        const bool conv_first = (int)blockIdx.x < CONV_WGS_P4;
        if (conv_first) p4_conversion(F);
#endif
#if HAVE_GDN
        for (;;) { const int it = dequeue(F, qw, 4); if (it < 0) break; p4_gdn_scan_item(F, it); }
#endif
        p4_attention(F, (char*)lds + RING_OFF, qw + 512);
#if CONV_IN_P4
        p4_conversion(F);
#endif
    }
    SEAM(4);
#if HAVE_GDN
    if (IN(5)) { p5_gdn_outnorm(F); }
#endif
    SEAM(5);
    if (IN(6)) {
        DenseOrder S; S.init(T / 256, DM / 256, F.G, (int)blockIdx.x);
        Gemm g{WSP(bf16, WS_YF), WSP(bf16, WS_WUFT), DM};
#if GATES_SIG == 3
        MidGateR M{WSP(bf16, WS_PROJ) + PC_GA, NPROJ};
        EpiGateOutS E{WSP(bf16, WS_PROJ) + PC_GB, NPROJ, WSP(bf16, WS_MERGED), DM};
        gemm_phase<EpiGateOutS, DenseOrder, true, true, false, MidGateR>(ring, g, S, E, M);
#elif GATES_SIG == 1
        MidGateS M{WSP(bf16, WS_PROJ) + PC_GA, WSP(bf16, WS_PROJ) + PC_GB, NPROJ};
        EpiGateOutS E{WSP(bf16, WS_PROJ) + PC_GB, NPROJ, WSP(bf16, WS_MERGED), DM};
        gemm_phase<EpiGateOutS, DenseOrder, true, true, false, MidGateS>(ring, g, S, E, M);
#else
        MidGate M{WSP(bf16, WS_PROJ) + PC_GA, WSP(bf16, WS_PROJ) + PC_GB, NPROJ};
        EpiGateOut E{WSP(bf16, WS_PROJ) + PC_GB, NPROJ, WSP(bf16, WS_MERGED), DM};
        gemm_phase<EpiGateOut, DenseOrder, true, true, false, MidGate>(ring, g, S, E, M);
#endif
    }
    SEAM(6);
    if (IN(7)) {
        Gemm g{WSP(bf16, WS_MERGED), WSP(bf16, WS_WOT), DM}; DenseOrder S; S.init(T / 256, DM / 256, F.G, (int)blockIdx.x);
        EpiBf16 E{WSP(bf16, WS_TMP), DM, nullptr, 0, 1.f};
        gemm_phase<EpiBf16, DenseOrder, true, true>(ring, g, S, E);
    }
    SEAM(7);
#if HAVE_MOE
    if (IN(8)) { p8_router(F); }
    SEAM(8);
    if (IN(9)) { p9_gather(F); }
    SEAM(9);
    if (IN(10)) { p10_gateup(F); }
    SEAM(10);
    if (IN(11)) { p11_down(F); }
    SEAM(11);
    if (IN(12)) { p12_combine(F); }
#endif
#undef IN
#undef SEAM
}

extern "C" void kernel_launch(void* const* d_in, const int* in_sizes, int n_in, void* d_out, int out_size, void* d_ws, size_t ws_size, hipStream_t stream) {
    static int grid = 0;
    if (grid == 0) {
        if (n_in != 20 || in_sizes[0] != T * DM || out_size != T * DM || ws_size < WS_END) { fprintf(stderr, "kernel_launch: unexpected shapes (n_in %d, in0 %d, out %d, ws %zu < %zu); nothing launched\n", n_in, n_in > 0 ? in_sizes[0] : -1, out_size, ws_size, (size_t)WS_END); grid = -1; return; }
        int dev = 0, cus = 0, per_cu = 0;
        if (hipGetDevice(&dev) != hipSuccess || hipDeviceGetAttribute(&cus, hipDeviceAttributeMultiprocessorCount, dev) != hipSuccess) { grid = -1; return; }
        if (hipFuncSetAttribute((const void*)fwd_kernel, hipFuncAttributeMaxDynamicSharedMemorySize, LDS_BYTES) != hipSuccess) { fprintf(stderr, "kernel_launch: hipFuncSetAttribute failed\n"); grid = -1; return; }
        if (hipOccupancyMaxActiveBlocksPerMultiprocessor(&per_cu, (const void*)fwd_kernel, NWAVES * 64, LDS_BYTES) != hipSuccess || per_cu < 1) fprintf(stderr, "kernel_launch: note: occupancy query reports %d workgroups per CU\n", per_cu);
        (void)hipGetLastError();
        grid = cus;
        if (grid != 256) fprintf(stderr, "kernel_launch: %d CUs; this kernel is laid out for 256\n", grid);
    }
    if (grid < 0) return;
    if (hipMemsetAsync((char*)d_ws + WS_CTL, 0, CTL_ZERO_BYTES, stream) != hipSuccess) return;
    Args a{};
    for (int i = 0; i < 20; ++i) a.in[i] = (const float*)d_in[i];
    a.out = (float*)d_out; a.ws = (unsigned char*)d_ws;
    static const int ranges[] = {MK_RANGES};
    for (int li = 0; 2 * li + 1 < (int)(sizeof(ranges) / sizeof(ranges[0])); ++li) { a.ph_lo = ranges[2 * li]; a.ph_hi = ranges[2 * li + 1]; a.li = li; hipLaunchKernelGGL(fwd_kernel, dim3(grid), dim3(NWAVES * 64), LDS_BYTES, stream, a); }
}
```

```cpp
#define MK_RANGES 0, 13
#define HAVE_GDN 1
#define HAVE_MOE 1
#define MOE_F8_GU 1
#define MOE_F8_DN 1
#define CONV_IN_P4 1
#define CONV_SHARE 3
#define GATES_F8 1
#define YB_F8 1
#define CONV_WGS_P4 96
#define X1_BF16 0
#define MOE_GATHER 1
#define GATES_SIG 1
#include <hip/hip_runtime.h>
#include <cstdio>
#include <cstdint>

#define GAS __attribute__((address_space(1)))
#define LAS __attribute__((address_space(3)))
typedef unsigned short bf16;
typedef short bf16x8 __attribute__((ext_vector_type(8)));
typedef short s16x4 __attribute__((ext_vector_type(4)));
typedef float f32x2 __attribute__((ext_vector_type(2)));
typedef float f32x4 __attribute__((ext_vector_type(4)));
typedef float f32x16 __attribute__((ext_vector_type(16)));
typedef unsigned u32x2 __attribute__((ext_vector_type(2)));
typedef unsigned u32x4 __attribute__((ext_vector_type(4)));
typedef GAS unsigned gu32;
#define RLX_AGENT __ATOMIC_RELAXED, __HIP_MEMORY_SCOPE_AGENT
#define LDS_WAIT() asm volatile("s_waitcnt lgkmcnt(0)" ::: "memory")
#define VM_WAIT() asm volatile("s_waitcnt vmcnt(0)" ::: "memory")

constexpr int BATCH = 2, SEQ = 8192, T = BATCH * SEQ, DM = 2048;
constexpr int NH = 8, HD = 128, FW = NH * HD;
constexpr int NE = 32, TOPK = 4, DFF = 2048;
constexpr int IN_COLS = 11288;
constexpr int NPROJ = 11264;
constexpr int PC_FQ = 0, PC_FK = 1024, PC_FV = 2048, PC_GQKV = 3072, PC_GZ = 6144, PC_GA = 7168, PC_GB = 9216;
constexpr int GCH = 64, NCHUNK = SEQ / GCH, NUNIT = BATCH * NH * NCHUNK;
constexpr int MAXSLOT = 73728;
constexpr float RMS_EPS = 1e-6f;
constexpr int NWAVES = 8;

typedef __bf16 bf16x2_t __attribute__((ext_vector_type(2)));
__device__ __forceinline__ unsigned cvt_pk_bf16(float lo, float hi) { const f32x2 v = {lo, hi}; return __builtin_bit_cast(unsigned, __builtin_convertvector(v, bf16x2_t)); }
__device__ __forceinline__ float bf_lo(unsigned w) { return __builtin_bit_cast(float, w << 16); }
__device__ __forceinline__ float bf_hi(unsigned w) { return __builtin_bit_cast(float, w & 0xffff0000u); }
__device__ __forceinline__ float bf2f(bf16 b) { return __builtin_bit_cast(float, (unsigned)b << 16); }
__device__ __forceinline__ bf16 f2bf(float f) { return (bf16)(cvt_pk_bf16(f, 0.f) & 0xffffu); }
__device__ __forceinline__ float sigmoidf_(float x) { return __builtin_amdgcn_rcpf(1.f + __expf(-x)); }
__device__ __forceinline__ float log1p_small(float e) { return e < 0.0078125f ? e * (1.f - e * (0.5f - e * 0.33333334f)) : __logf(1.f + e); }
__device__ __forceinline__ int crow(int r, int hi) { return (r & 3) + 8 * (r >> 2) + 4 * hi; }
__device__ __forceinline__ float sum16_dpp(float v) {
    v += __builtin_bit_cast(float, __builtin_amdgcn_mov_dpp(__builtin_bit_cast(int, v), 0xB1, 0xF, 0xF, true));
    v += __builtin_bit_cast(float, __builtin_amdgcn_mov_dpp(__builtin_bit_cast(int, v), 0x4E, 0xF, 0xF, true));
    v += __builtin_bit_cast(float, __builtin_amdgcn_mov_dpp(__builtin_bit_cast(int, v), 0x141, 0xF, 0xF, true));
    v += __builtin_bit_cast(float, __builtin_amdgcn_mov_dpp(__builtin_bit_cast(int, v), 0x140, 0xF, 0xF, true));
    return v;
}
__device__ __forceinline__ float wave_sum(float v) {
#pragma unroll
    for (int o = 1; o < 64; o <<= 1) v += __shfl_xor(v, o);
    return v;
}

namespace pg8 {
#define PG8_LAS __attribute__((address_space(3)))
typedef unsigned short bf16_t;
constexpr int BM = 256, BK = 64, HALF = 128, HTB = HALF * BK * 2  , STAGE_BYTES = 8 * HTB, NXCD = 8, WGM = 8;
__host__ __device__ __forceinline__ int lds_byte(int r, int c) { const int st = (r >> 4) * 2 + (c >> 5), rr = r & 15, cc = c & 31, ob = rr * 64 + cc * 2; return st * 1024 + (ob ^ (((ob >> 9) & 1) << 5)); }
__host__ __device__ __forceinline__ void stage_rc(int b, int& R, int& C) { const int st = b / 1024, sb = b % 1024, swz = sb ^ (((sb >> 9) & 1) << 5); R = (st >> 1) * 16 + swz / 64; C = (st & 1) * 32 + (swz % 64) / 2; }
__host__ __device__ __forceinline__ int perm32(int rho) { const int n = rho >> 4, i = rho & 15; return 8 * (i >> 2) + 4 * n + (i & 3); }

struct Unit { int arow, brow, pm, pn, e; };
struct Gemm { const bf16_t* A; const bf16_t* Bt; int K; const PG8_LAS unsigned short* rowtab; };

struct DenseOrder {
    int nM, nN, nwg, G, c;
    __device__ void init(int nM_, int nN_, int G_, int c_) { nM = nM_; nN = nN_; nwg = nM * nN; G = G_; c = c_; }
    __device__ bool tile(int i, int& pm, int& pn) const {
        const int L = i * G + c; if (L >= nwg) return false;
        int wgid = L; { const int q = nwg / NXCD, r = nwg % NXCD, xcd = wgid % NXCD, off = wgid / NXCD; wgid = (xcd < r ? xcd * (q + 1) : r * (q + 1) + (xcd - r) * q) + off; }
        const int nig = WGM * nN, gid = wgid / nig, fm = gid * WGM, gsz = (nM - fm) < WGM ? (nM - fm) : WGM;
        pm = fm + ((wgid % nig) % gsz); pn = (wgid % nig) / gsz; return true;
    }
    __device__ bool next(int i, Unit& u) const { if (!tile(i, u.pm, u.pn)) return false; u.arow = u.pm * BM; u.brow = u.pn * BM; u.e = 0; return true; }
    __device__ __forceinline__ void a_ready(const Unit&) const {}
    __device__ __forceinline__ void done(const Unit&) const {}
};
struct MoeOrder : DenseOrder {
    const PG8_LAS int* tile_e; int nrows_e;
    __device__ bool next(int i, Unit& u) const { if (!tile(i, u.pm, u.pn)) return false; u.e = __builtin_amdgcn_readfirstlane(tile_e[u.pm]); u.arow = u.pm * BM; u.brow = u.e * nrows_e + u.pn * BM; return true; }
};
typedef int i32x8 __attribute__((ext_vector_type(8)));
typedef int i32x4 __attribute__((ext_vector_type(4)));
__device__ __forceinline__ i32x8 cat8(const bf16x8 lo, const bf16x8 hi) { const i32x4 a = __builtin_bit_cast(i32x4, lo), b = __builtin_bit_cast(i32x4, hi); return __builtin_shufflevector(a, b, 0, 1, 2, 3, 4, 5, 6, 7); }
__device__ __forceinline__ unsigned pk4_fp8(float a, float b, float c, float d) {
    a = __builtin_amdgcn_fmed3f(a, -448.f, 448.f); b = __builtin_amdgcn_fmed3f(b, -448.f, 448.f); c = __builtin_amdgcn_fmed3f(c, -448.f, 448.f); d = __builtin_amdgcn_fmed3f(d, -448.f, 448.f);
    int w = 0; w = __builtin_amdgcn_cvt_pk_fp8_f32(a, b, w, false); w = __builtin_amdgcn_cvt_pk_fp8_f32(c, d, w, true); return (unsigned)w; }
constexpr float W8_SCALE = 64.f, W8_INV = 1.f / 64.f;
__device__ __forceinline__ u32x4 pack8(const f32x4 v0, const f32x4 v1) { u32x4 w; w.x = cvt_pk_bf16(v0[0], v0[1]); w.y = cvt_pk_bf16(v0[2], v0[3]); w.z = cvt_pk_bf16(v1[0], v1[1]); w.w = cvt_pk_bf16(v1[2], v1[3]); return w; }
__device__ __forceinline__ void unpack8(const u32x4 w, f32x4& v0, f32x4& v1) { v0 = (f32x4){bf_lo(w.x), bf_hi(w.x), bf_lo(w.y), bf_hi(w.y)}; v1 = (f32x4){bf_lo(w.z), bf_hi(w.z), bf_lo(w.w), bf_hi(w.w)}; }
__device__ __forceinline__ f32x4 sig4(const f32x4 x) { return (f32x4){sigmoidf_(x[0]), sigmoidf_(x[1]), sigmoidf_(x[2]), sigmoidf_(x[3])}; }

struct EpiBf16 {
    static constexpr bool PERM = true, AFTER_DRAIN = false;
    bf16_t* O; int ldc; const float* bias; int bias_stride_e; float scale;
    __device__ __forceinline__ void operator()(const f32x4 (&acc)[2][2][4][2], const Unit& u, int wr, int wc, int fr, int fq) const {
        const int row0 = u.arow + wr * 64 + fr, col0 = u.pn * BM + wc * 32 + 8 * fq;
        f32x4 bv[2][2];
#pragma unroll
        for (int bj = 0; bj < 2; ++bj)
#pragma unroll
            for (int n = 0; n < 2; ++n) bv[bj][n] = bias ? *(const f32x4*)(bias + (size_t)u.e * bias_stride_e + col0 + bj * HALF + 4 * n) : (f32x4){0.f, 0.f, 0.f, 0.f};
#pragma unroll
        for (int ai = 0; ai < 2; ++ai)
#pragma unroll
            for (int m = 0; m < 4; ++m) { bf16_t* rowp = O + (size_t)(row0 + ai * HALF + m * 16) * ldc + col0;
#pragma unroll
                for (int bj = 0; bj < 2; ++bj) *(u32x4*)(rowp + bj * HALF) = pack8(acc[ai][bj][m][0] * scale + bv[bj][0], acc[ai][bj][m][1] * scale + bv[bj][1]); }
    }
};
struct EpiF8 {
    static constexpr bool PERM = true, AFTER_DRAIN = false;
    unsigned char* O; int ldc; const float* bias; int bias_stride_e; float scale;
    __device__ __forceinline__ void operator()(const f32x4 (&acc)[2][2][4][2], const Unit& u, int wr, int wc, int fr, int fq) const {
        const int row0 = u.arow + wr * 64 + fr, col0 = u.pn * BM + wc * 32 + 8 * fq;
        f32x4 bv[2][2];
#pragma unroll
        for (int bj = 0; bj < 2; ++bj)
#pragma unroll
            for (int n = 0; n < 2; ++n) bv[bj][n] = *(const f32x4*)(bias + (size_t)u.e * bias_stride_e + col0 + bj * HALF + 4 * n);
#pragma unroll
        for (int ai = 0; ai < 2; ++ai)
#pragma unroll
            for (int m = 0; m < 4; ++m) { unsigned char* rowp = O + (size_t)(row0 + ai * HALF + m * 16) * ldc + col0;
#pragma unroll
                for (int bj = 0; bj < 2; ++bj) { const f32x4 v0 = acc[ai][bj][m][0] * scale + bv[bj][0], v1 = acc[ai][bj][m][1] * scale + bv[bj][1];
                    u32x2 w; w.x = pk4_fp8(v0[0], v0[1], v0[2], v0[3]); w.y = pk4_fp8(v1[0], v1[1], v1[2], v1[3]); *(u32x2*)(rowp + bj * HALF) = w; } }
    }
};
template <int MODE> struct EpiGate {
    static constexpr bool PERM = true, AFTER_DRAIN = false;
    const bf16_t* gate; int gld; float* tmp; bf16_t* O; int ldc;
    __device__ __forceinline__ void operator()(const f32x4 (&acc)[2][2][4][2], const Unit& u, int wr, int wc, int fr, int fq) const {
        const int row0 = u.arow + wr * 64 + fr, col0 = u.pn * BM + wc * 32 + 8 * fq;
#pragma unroll
        for (int ai = 0; ai < 2; ++ai)
#pragma unroll
            for (int m = 0; m < 4; ++m) { const size_t row = (size_t)(row0 + ai * HALF + m * 16);
#pragma unroll
                for (int bj = 0; bj < 2; ++bj) { const int col = col0 + bj * HALF;
                    f32x4 g0, g1; unpack8(*(const u32x4*)(gate + row * gld + col), g0, g1);
                    f32x4 v0 = sig4(g0) * acc[ai][bj][m][0], v1 = sig4(g1) * acc[ai][bj][m][1];
                    if (MODE == 1) { *(f32x4*)(tmp + row * ldc + col) = v0; *(f32x4*)(tmp + row * ldc + col + 4) = v1; }
                    else { if (MODE == 2) { v0 += *(const f32x4*)(tmp + row * ldc + col); v1 += *(const f32x4*)(tmp + row * ldc + col + 4); }
                        *(u32x4*)(O + row * ldc + col) = pack8(v0, v1); } }
                asm volatile("" ::: "memory"); }
    }
};
struct NoMid { static constexpr bool ON = false; __device__ __forceinline__ void operator()(f32x4 (&)[2][2][4][2], const Unit&, int, int, int, int) const {} };
struct MidGate {
    static constexpr bool ON = true;
    const bf16_t* ga; const bf16_t* gb; int gld;
    __device__ __forceinline__ void operator()(f32x4 (&acc)[2][2][4][2], const Unit& u, int wr, int wc, int fr, int fq) const {
        const int row0 = u.arow + wr * 64 + fr, col0 = u.pn * BM + wc * 32 + 8 * fq;
#pragma unroll
        for (int ai = 0; ai < 2; ++ai)
#pragma unroll
            for (int m = 0; m < 4; ++m) { const size_t row = (size_t)(row0 + ai * HALF + m * 16);
#pragma unroll
                for (int bj = 0; bj < 2; ++bj) { const int col = col0 + bj * HALF;
                    f32x4 a0, a1, b0, b1; unpack8(*(const u32x4*)(ga + row * gld + col), a0, a1); unpack8(*(const u32x4*)(gb + row * gld + col), b0, b1);
#pragma unroll
                    for (int j = 0; j < 4; ++j) { acc[ai][bj][m][0][j] *= (1.f + __expf(-fmaxf(b0[j], -30.f))) * __builtin_amdgcn_rcpf(1.f + __expf(-a0[j])); acc[ai][bj][m][1][j] *= (1.f + __expf(-fmaxf(b1[j], -30.f))) * __builtin_amdgcn_rcpf(1.f + __expf(-a1[j])); } }
                asm volatile("" ::: "memory"); }
    }
};
struct EpiGateOut {
    static constexpr bool PERM = true, AFTER_DRAIN = false;
    const bf16_t* gate; int gld; bf16_t* O; int ldc;
    __device__ __forceinline__ void operator()(const f32x4 (&acc)[2][2][4][2], const Unit& u, int wr, int wc, int fr, int fq) const {
        const int row0 = u.arow + wr * 64 + fr, col0 = u.pn * BM + wc * 32 + 8 * fq;
#pragma unroll
        for (int ai = 0; ai < 2; ++ai)
#pragma unroll
            for (int m = 0; m < 4; ++m) { const size_t row = (size_t)(row0 + ai * HALF + m * 16);
#pragma unroll
                for (int bj = 0; bj < 2; ++bj) { const int col = col0 + bj * HALF;
                    f32x4 g0, g1; unpack8(*(const u32x4*)(gate + row * gld + col), g0, g1);
#pragma unroll
                    for (int j = 0; j < 4; ++j) { g0[j] = fmaxf(g0[j], -30.f); g1[j] = fmaxf(g1[j], -30.f); }
                    *(u32x4*)(O + row * ldc + col) = pack8(sig4(g0) * acc[ai][bj][m][0], sig4(g1) * acc[ai][bj][m][1]); }
                asm volatile("" ::: "memory"); }
    }
};
struct EpiResid {
    static constexpr bool PERM = false, AFTER_DRAIN = false;
    const float* base; float* out; int ldc;
    __device__ __forceinline__ void operator()(const f32x4 (&acc)[2][2][4][2], const Unit& u, int wr, int wc, int fr, int fq) const {
        const int row0 = u.arow + wr * 64 + fr, col0 = u.pn * BM + wc * 32 + 4 * fq;
#pragma unroll
        for (int ai = 0; ai < 2; ++ai)
#pragma unroll
            for (int m = 0; m < 4; ++m) { const size_t off = (size_t)(row0 + ai * HALF + m * 16) * ldc + col0;
#pragma unroll
                for (int bj = 0; bj < 2; ++bj)
#pragma unroll
                    for (int n = 0; n < 2; ++n) *(f32x4*)(out + off + bj * HALF + n * 16) = *(const f32x4*)(base + off + bj * HALF + n * 16) + acc[ai][bj][m][n];
                asm volatile("" ::: "memory"); }
    }
};
__device__ __forceinline__ f32x2 pk_fma(f32x2 a, f32x2 b, f32x2 c) { f32x2 r; asm("v_pk_fma_f32 %0, %1, %2, %3" : "=v"(r) : "v"(a), "v"(b), "v"(c)); return r; }
__device__ __forceinline__ f32x2 pk_mul(f32x2 a, f32x2 b) { f32x2 r; asm("v_pk_mul_f32 %0, %1, %2" : "=v"(r) : "v"(a), "v"(b)); return r; }
__device__ __forceinline__ f32x2 pk_add(f32x2 a, f32x2 b) { f32x2 r; asm("v_pk_add_f32 %0, %1, %2" : "=v"(r) : "v"(a), "v"(b)); return r; }
__device__ __forceinline__ f32x2 pk_mul_t(f32x2 a, f32x2 b) { f32x2 r; asm("s_nop 0\n\tv_pk_mul_f32 %0, %1, %2" : "=v"(r) : "v"(a), "v"(b)); return r; }
__device__ __forceinline__ f32x2 pk_add_t(f32x2 a, f32x2 b) { f32x2 r; asm("s_nop 0\n\tv_pk_add_f32 %0, %1, %2" : "=v"(r) : "v"(a), "v"(b)); return r; }
template <bool O8> struct EpiSwiglu {
    static constexpr bool PERM = true, AFTER_DRAIN = false;
    void* O; int ldc; const float* bias; float scale;
    __device__ __forceinline__ void operator()(const f32x4 (&acc)[2][2][4][2], const Unit& u, int wr, int wc, int fr, int fq) const {
        const int row0 = u.arow + wr * 64 + fr, cin = wc * 32 + 8 * fq, ocol = u.pn * HALF + cin;
        const float* bp = bias + (size_t)u.e * 4096 + u.pn * BM + cin;
        f32x4 bg[2], bl[2];
#pragma unroll
        for (int n = 0; n < 2; ++n) { bg[n] = *(const f32x4*)(bp + 4 * n); bl[n] = *(const f32x4*)(bp + HALF + 4 * n); }
        const f32x2 sc2 = {scale, scale}, one2 = {1.f, 1.f}, ce2 = {-1.702f * 1.4426950408889634f, -1.702f * 1.4426950408889634f};
#pragma unroll
        for (int ai = 0; ai < 2; ++ai)
#pragma unroll
            for (int m = 0; m < 4; ++m) { f32x4 a[2];
#pragma unroll
                for (int n = 0; n < 2; ++n) { const f32x4 G = acc[ai][0][m][n], L = acc[ai][1][m][n];
#pragma unroll
                    for (int h = 0; h < 2; ++h) {
                        f32x2 g = pk_fma((f32x2){G[2 * h], G[2 * h + 1]}, sc2, (f32x2){bg[n][2 * h], bg[n][2 * h + 1]}), l = pk_fma((f32x2){L[2 * h], L[2 * h + 1]}, sc2, (f32x2){bl[n][2 * h], bl[n][2 * h + 1]});
                        g[0] = __builtin_amdgcn_fmed3f(g[0], -3.0e38f, 7.f); g[1] = __builtin_amdgcn_fmed3f(g[1], -3.0e38f, 7.f);     l[0] = __builtin_amdgcn_fmed3f(l[0], -7.f, 7.f); l[1] = __builtin_amdgcn_fmed3f(l[1], -7.f, 7.f);
                        f32x2 t = pk_mul(g, ce2); t[0] = __builtin_amdgcn_exp2f(t[0]); t[1] = __builtin_amdgcn_exp2f(t[1]); t = pk_add_t(t, one2); t[0] = __builtin_amdgcn_rcpf(t[0]); t[1] = __builtin_amdgcn_rcpf(t[1]);
                        const f32x2 o = pk_mul(pk_mul_t(g, t), pk_add(l, one2)); a[n][2 * h] = o[0]; a[n][2 * h + 1] = o[1]; } }
                const size_t off = (size_t)(row0 + ai * HALF + m * 16) * ldc + ocol;
                if constexpr (O8) { u32x2 w; w.x = pk4_fp8(a[0][0], a[0][1], a[0][2], a[0][3]); w.y = pk4_fp8(a[1][0], a[1][1], a[1][2], a[1][3]); *(u32x2*)((unsigned char*)O + off) = w; }
                else *(u32x4*)((bf16_t*)O + off) = pack8(a[0], a[1]); }
    }
};

struct EpiProj {
    static constexpr bool PERM = true, AFTER_DRAIN = false;
    bf16_t* proj; bf16_t* qn; bf16_t* kn; const float* wq; const float* wk; PG8_LAS float* ss; bf16_t* vn;
    __device__ __forceinline__ void operator()(const f32x4 (&acc)[2][2][4][2], const Unit& u, int wr, int wc, int fr, int fq) const {
        const int rloc = wr * 64 + fr, cin = wc * 32 + 8 * fq;
        if (u.pn >= 8) {
            const bool isv = u.pn < 12; const size_t pitch = isv ? (size_t)1024 : (size_t)NPROJ;
            bf16_t* o = (isv ? vn + (u.pn - 8) * BM : proj + u.pn * BM) + (size_t)(u.arow + rloc) * pitch + cin;
#pragma unroll
            for (int ai = 0; ai < 2; ++ai)
#pragma unroll
                for (int m = 0; m < 4; ++m) { bf16_t* rowp = o + (size_t)(ai * HALF + m * 16) * pitch;
#pragma unroll
                    for (int bj = 0; bj < 2; ++bj) *(u32x4*)(rowp + bj * HALF) = pack8(acc[ai][bj][m][0], acc[ai][bj][m][1]); }
        } else {
#pragma unroll
            for (int ai = 0; ai < 2; ++ai)
#pragma unroll
                for (int m = 0; m < 4; ++m)
#pragma unroll
                    for (int bj = 0; bj < 2; ++bj) { const f32x4 a = acc[ai][bj][m][0], b = acc[ai][bj][m][1];
                        float p = ((a[0] * a[0] + a[1] * a[1]) + (a[2] * a[2] + a[3] * a[3])) + ((b[0] * b[0] + b[1] * b[1]) + (b[2] * b[2] + b[3] * b[3]));
                        p += __shfl_xor(p, 16); p += __shfl_xor(p, 32);
                        if (fq == 0) ss[((ai * HALF + m * 16 + rloc) * 2 + bj) * 4 + wc] = p; }
            asm volatile("s_waitcnt lgkmcnt(0)" ::: "memory"); __builtin_amdgcn_s_barrier();
            const float* w = (u.pn < 4 ? wq : wk) + cin; const f32x4 w0 = *(const f32x4*)w, w1 = *(const f32x4*)(w + 4);
            bf16_t* o = (u.pn < 4 ? qn : kn) + (size_t)(u.arow + rloc) * 1024 + (u.pn & 3) * BM + cin;
#pragma unroll
            for (int ai = 0; ai < 2; ++ai)
#pragma unroll
                for (int m = 0; m < 4; ++m) { const f32x4 s0 = *(const PG8_LAS f32x4*)(ss + (ai * HALF + m * 16 + rloc) * 8), s1 = *(const PG8_LAS f32x4*)(ss + (ai * HALF + m * 16 + rloc) * 8 + 4);
                    const float r0 = rsqrtf(((s0[0] + s0[1]) + (s0[2] + s0[3])) * (1.f / 128.f) + 1e-6f), r1 = rsqrtf(((s1[0] + s1[1]) + (s1[2] + s1[3])) * (1.f / 128.f) + 1e-6f);
                    bf16_t* rowp = o + (size_t)(ai * HALF + m * 16) * 1024;
                    *(u32x4*)rowp = pack8(acc[ai][0][m][0] * r0 * w0, acc[ai][0][m][1] * r0 * w1);
                    *(u32x4*)(rowp + HALF) = pack8(acc[ai][1][m][0] * r1 * w0, acc[ai][1][m][1] * r1 * w1); }
            asm volatile("s_waitcnt lgkmcnt(0)" ::: "memory"); __builtin_amdgcn_s_barrier();
        }
    }
};
struct EpiSig {
    static constexpr bool PERM = true, AFTER_DRAIN = false;
    bf16_t* O; int ldc_unused; float scale;
    __device__ __forceinline__ void operator()(const f32x4 (&acc)[2][2][4][2], const Unit& u, int wr, int wc, int fr, int fq) const {
        const float lo = (u.pn >> 3) ? -30.f : -88.f;
        unsigned char* base = (unsigned char*)(O + (size_t)(u.arow + wr * 64 + fr) * NPROJ + (u.pn * BM + wc * 32 + 8 * fq));
#pragma unroll
        for (int ai = 0; ai < 2; ++ai)
#pragma unroll
            for (int m = 0; m < 4; ++m) {
#pragma unroll
                for (int bj = 0; bj < 2; ++bj) { f32x4 s0, s1;
#pragma unroll
                    for (int j = 0; j < 4; ++j) { s0[j] = __builtin_amdgcn_rcpf(1.f + __expf(-fmaxf(acc[ai][bj][m][0][j] * scale, lo))); s1[j] = __builtin_amdgcn_rcpf(1.f + __expf(-fmaxf(acc[ai][bj][m][1][j] * scale, lo))); }
                    *(u32x4*)(base + ((size_t)(ai * HALF + m * 16) * NPROJ + bj * HALF) * 2) = pack8(s0, s1); }
                asm volatile("" ::: "memory"); }
    }
};
struct MidGateS {
    static constexpr bool ON = true;
    const bf16_t* ga; const bf16_t* gb; int gld;
    __device__ __forceinline__ void operator()(f32x4 (&acc)[2][2][4][2], const Unit& u, int wr, int wc, int fr, int fq) const {
        const int row0 = u.arow + wr * 64 + fr, col0 = u.pn * BM + wc * 32 + 8 * fq;
#pragma unroll
        for (int ai = 0; ai < 2; ++ai)
#pragma unroll
            for (int m = 0; m < 4; ++m) { const size_t row = (size_t)(row0 + ai * HALF + m * 16);
#pragma unroll
                for (int bj = 0; bj < 2; ++bj) { const int col = col0 + bj * HALF;
                    f32x4 a0, a1, b0, b1; unpack8(*(const u32x4*)(ga + row * gld + col), a0, a1); unpack8(*(const u32x4*)(gb + row * gld + col), b0, b1);
#pragma unroll
                    for (int j = 0; j < 4; ++j) { acc[ai][bj][m][0][j] *= a0[j] * __builtin_amdgcn_rcpf(b0[j]); acc[ai][bj][m][1][j] *= a1[j] * __builtin_amdgcn_rcpf(b1[j]); } }
                asm volatile("" ::: "memory"); }
    }
};
struct EpiGateOutS {
    static constexpr bool PERM = true, AFTER_DRAIN = false;
    const bf16_t* gate; int gld; bf16_t* O; int ldc;
    __device__ __forceinline__ void operator()(const f32x4 (&acc)[2][2][4][2], const Unit& u, int wr, int wc, int fr, int fq) const {
        const int row0 = u.arow + wr * 64 + fr, col0 = u.pn * BM + wc * 32 + 8 * fq;
#pragma unroll
        for (int ai = 0; ai < 2; ++ai)
#pragma unroll
            for (int m = 0; m < 4; ++m) { const size_t row = (size_t)(row0 + ai * HALF + m * 16);
#pragma unroll
                for (int bj = 0; bj < 2; ++bj) { const int col = col0 + bj * HALF;
                    f32x4 g0, g1; unpack8(*(const u32x4*)(gate + row * gld + col), g0, g1);
                    *(u32x4*)(O + row * ldc + col) = pack8(g0 * acc[ai][bj][m][0], g1 * acc[ai][bj][m][1]); }
                asm volatile("" ::: "memory"); }
    }
};
struct EpiSigRS {
    static constexpr bool PERM = true, AFTER_DRAIN = false;
    bf16_t* OR; bf16_t* OS; float scale;
    __device__ __forceinline__ void operator()(const f32x4 (&acc)[2][2][4][2], const Unit& u, int wr, int wc, int fr, int fq) const {
        const size_t o0 = (size_t)(u.arow + wr * 64 + fr) * NPROJ + (u.pn * HALF + wc * 32 + 8 * fq);
        unsigned char* pr = (unsigned char*)(OR + o0); unsigned char* ps = (unsigned char*)(OS + o0);
#pragma unroll
        for (int ai = 0; ai < 2; ++ai)
#pragma unroll
            for (int m = 0; m < 4; ++m) { f32x4 r[2], s[2];
#pragma unroll
                for (int n = 0; n < 2; ++n)
#pragma unroll
                    for (int j = 0; j < 4; ++j) { const float eb = 1.f + __expf(-fmaxf(acc[ai][1][m][n][j] * scale, -30.f)); s[n][j] = __builtin_amdgcn_rcpf(eb); r[n][j] = eb * __builtin_amdgcn_rcpf(1.f + __expf(-fmaxf(acc[ai][0][m][n][j] * scale, -88.f))); }
                *(u32x4*)(pr + (size_t)(ai * HALF + m * 16) * NPROJ * 2) = pack8(r[0], r[1]); *(u32x4*)(ps + (size_t)(ai * HALF + m * 16) * NPROJ * 2) = pack8(s[0], s[1]);
                asm volatile("" ::: "memory"); }
    }
};
struct MidGateR {
    static constexpr bool ON = true;
    const bf16_t* gr; int gld;
    __device__ __forceinline__ void operator()(f32x4 (&acc)[2][2][4][2], const Unit& u, int wr, int wc, int fr, int fq) const {
        const int row0 = u.arow + wr * 64 + fr, col0 = u.pn * BM + wc * 32 + 8 * fq;
#pragma unroll
        for (int ai = 0; ai < 2; ++ai)
#pragma unroll
            for (int m = 0; m < 4; ++m) { const size_t row = (size_t)(row0 + ai * HALF + m * 16);
#pragma unroll
                for (int bj = 0; bj < 2; ++bj) { f32x4 a0, a1; unpack8(*(const u32x4*)(gr + row * gld + col0 + bj * HALF), a0, a1); acc[ai][bj][m][0] *= a0; acc[ai][bj][m][1] *= a1; }
                asm volatile("" ::: "memory"); }
    }
};
template <class Epi, class Sched, bool ALIGN_EPI = false, bool SP2 = false, bool F8 = false, class Mid = NoMid, bool GATHER = false>
__device__ __forceinline__ void gemm_phase(PG8_LAS unsigned char* lds, const Gemm g, const Sched& S, const Epi& E, const Mid& M = Mid()) {
    const int tid = threadIdx.x, wid = __builtin_amdgcn_readfirstlane(tid >> 6), lane = tid & 63, wr = wid >> 2, wc = wid & 3, fr = lane & 15, fq = lane >> 4;
    const int K = g.K, nt = K / BK;
    unsigned voffA[2], voffB[2];
#pragma unroll
    for (int i = 0; i < 2; ++i) { int R, C; stage_rc(tid * 16 + i * 8192, R, C); const int Rb = Epi::PERM ? ((R & ~31) + perm32(R & 31)) : R;
        voffA[i] = (unsigned)(R * K + C) * 2u; voffB[i] = (unsigned)(Rb * K + C) * 2u; }
    const size_t kstep = (size_t)(BK * 2);
    const size_t hstep = (size_t)HALF * K * 2;
    const size_t hstepA = GATHER ? (size_t)0 : hstep; static_assert(!GATHER || SP2, "GATHER is wired into the SP2 loop only");
    const unsigned ldsw = (unsigned)wid * 1024u;
    const int aoff = lds_byte(wr * 64 + fr, fq * 8), boff = lds_byte(wc * 32 + fr, fq * 8);
#define PG8_SA(b, h) (((b) * 2 + (h)) * HTB)
#define PG8_SB(b, h) ((4 + (b) * 2 + (h)) * HTB)
#define PG8_STAGE(bufoff, gbase, voff) do { _Pragma("unroll") for (int _i = 0; _i < 2; ++_i) { unsigned _vo = (voff)[_i]; asm volatile("" : "+v"(_vo));     \
        __builtin_amdgcn_global_load_lds((const unsigned*)((const char*)(gbase) + _vo), (PG8_LAS unsigned*)(lds + (bufoff) + ldsw + _i * 8192), 16, 0, 0); } } while (0)
#define PG8_LDA(dst, b, h) do { _Pragma("unroll") for (int m = 0; m < 4; ++m) _Pragma("unroll") for (int k = 0; k < 2; ++k) dst[m][k] = *(const PG8_LAS bf16x8*)(lds + PG8_SA(b, h) + aoff + m * 2048 + k * 1024); } while (0)
#define PG8_LDB(dst, b, h) do { _Pragma("unroll") for (int n = 0; n < 2; ++n) _Pragma("unroll") for (int k = 0; k < 2; ++k) dst[n][k] = *(const PG8_LAS bf16x8*)(lds + PG8_SB(b, h) + boff + n * 2048 + k * 1024); } while (0)
#define PG8_MMA(ai, bj, At, Bt) do { __builtin_amdgcn_s_setprio(1); \
        if constexpr (F8) { _Pragma("unroll") for (int m = 0; m < 4; ++m) _Pragma("unroll") for (int n = 0; n < 2; ++n) \
            acc[ai][bj][m][n] = __builtin_amdgcn_mfma_scale_f32_16x16x128_f8f6f4(cat8(Bt[n][0], Bt[n][1]), cat8(At[m][0], At[m][1]), acc[ai][bj][m][n], 0, 0, 0, 0, 0, 0); }     \
        else { _Pragma("unroll") for (int m = 0; m < 4; ++m) _Pragma("unroll") for (int n = 0; n < 2; ++n) _Pragma("unroll") for (int k = 0; k < 2; ++k) \
            acc[ai][bj][m][n] = __builtin_amdgcn_mfma_f32_16x16x32_bf16(Bt[n][k], At[m][k], acc[ai][bj][m][n], 0, 0, 0); } \
        __builtin_amdgcn_s_setprio(0); } while (0)
#define PG8_WAIT_V(n) asm volatile("s_waitcnt vmcnt(" #n ")" ::: "memory")
#define PG8_WAIT_L(n) asm volatile("s_waitcnt lgkmcnt(" #n ")" ::: "memory")
#define PG8_BAR __builtin_amdgcn_s_barrier()
#define PG8_SCHED __builtin_amdgcn_sched_barrier(0)
    Unit cur, nxt; int ui = 0;
    if (!S.next(0, cur)) return;
    f32x4 acc[2][2][4][2];
#pragma unroll
    for (int a = 0; a < 2; ++a)
#pragma unroll
        for (int b = 0; b < 2; ++b)
#pragma unroll
            for (int m = 0; m < 4; ++m)
#pragma unroll
                for (int n = 0; n < 2; ++n) acc[a][b][m][n] = (f32x4){0.f, 0.f, 0.f, 0.f};
    bf16x8 At[4][2], B0[2][2], B1[2][2];
    unsigned va[2][2];
#pragma unroll
    for (int h = 0; h < 2; ++h) { va[h][0] = voffA[0]; va[h][1] = voffA[1]; }
#define PG8_GLOADH(uidx, h) do { int _t; asm volatile("v_mov_b32 %0, %1" : "=v"(_t) : "v"(tid)); const int _sb = (_t & 63) * 16, _sw = _sb ^ (((_sb >> 9) & 1) << 5), _st = _t >> 6; \
        const int _R = (_st >> 1) * 16 + (_sw >> 6); const unsigned _C2 = (unsigned)(((_st & 1) * 32 + ((_sw & 63) >> 1)) * 2); const PG8_LAS unsigned short* _tp = g.rowtab + (uidx) * 256 + (h) * 128 + _R; \
        va[h][0] = (unsigned)_tp[0] * (unsigned)(K * 2) + _C2; va[h][1] = (unsigned)_tp[64] * (unsigned)(K * 2) + _C2; } while (0)
    const size_t rstep = (size_t)K * 2;
    const char* cA = (const char*)g.A + (GATHER ? (size_t)0 : (size_t)cur.arow * rstep); const char* cB = (const char*)g.Bt + (size_t)cur.brow * rstep;
    S.a_ready(cur);
    if constexpr (GATHER) { PG8_GLOADH(0, 0); PG8_GLOADH(0, 1); }
    if constexpr (SP2) {
        PG8_STAGE(PG8_SB(0, 0), cB, voffB); PG8_STAGE(PG8_SB(0, 1), cB + hstep, voffB); PG8_STAGE(PG8_SA(0, 0), cA, va[0]); PG8_STAGE(PG8_SA(0, 1), cA + hstepA, va[1]);
        if (wr == 1) PG8_BAR;
        PG8_WAIT_V(2); PG8_BAR;
        PG8_STAGE(PG8_SB(1, 0), cB + kstep, voffB); PG8_STAGE(PG8_SA(1, 0), cA + kstep, va[0]); PG8_STAGE(PG8_SB(1, 1), cB + hstep + kstep, voffB);
        PG8_WAIT_V(6); PG8_BAR;
    } else {
        PG8_STAGE(PG8_SB(0, 0), cB, voffB); PG8_STAGE(PG8_SA(0, 0), cA, voffA); PG8_STAGE(PG8_SB(0, 1), cB + hstep, voffB); PG8_STAGE(PG8_SA(0, 1), cA + hstep, voffA);
        if (wr == 1) PG8_BAR;
        PG8_WAIT_V(4); PG8_BAR;
        PG8_STAGE(PG8_SB(1, 0), cB + kstep, voffB); PG8_STAGE(PG8_SA(1, 0), cA + kstep, voffA); PG8_STAGE(PG8_SB(1, 1), cB + hstep + kstep, voffB);
        PG8_WAIT_V(6); PG8_BAR;
    }
    for (;;) {
        const bool has_next = S.next(ui + 1, nxt);
        const char* nA = (has_next && !GATHER) ? (const char*)g.A + (size_t)nxt.arow * rstep : cA; const char* nB = has_next ? (const char*)g.Bt + (size_t)nxt.brow * rstep : cB;
        for (int t = 0; t < nt; t += 2) {
            const bool last = (t == nt - 2);
            const char* a1 = cA + (size_t)(t + 1) * kstep;
            const char* a2 = last ? nA : cA + (size_t)(t + 2) * kstep; const char* b2 = last ? nB : cB + (size_t)(t + 2) * kstep;
            const char* a3 = a2 + kstep; const char* b3 = b2 + kstep;
            if (last && has_next) S.a_ready(nxt);
            if constexpr (GATHER) { if (last && has_next) PG8_GLOADH(ui + 1, 0); }
            if constexpr (Mid::ON) { if (t == nt / 2) { int lq; asm volatile("v_mov_b32 %0, %1" : "=v"(lq) : "v"(lane)); M(acc, cur, wr, wc, lq & 15, lq >> 4); } }
            if constexpr (SP2) {
            PG8_LDB(B0, 0, 0); PG8_LDB(B1, 0, 1); PG8_SCHED; PG8_LDA(At, 0, 0); PG8_STAGE(PG8_SA(1, 1), a1 + hstepA, va[1]);
            if constexpr (GATHER) { if (last && has_next) PG8_GLOADH(ui + 1, 1); }
            PG8_WAIT_V(8); PG8_WAIT_L(0); PG8_BAR; PG8_MMA(0, 0, At, B0); PG8_MMA(0, 1, At, B1); PG8_BAR; PG8_SCHED;
            PG8_LDA(At, 0, 1); PG8_STAGE(PG8_SB(0, 0), b2, voffB); PG8_STAGE(PG8_SB(0, 1), b2 + hstep, voffB); PG8_STAGE(PG8_SA(0, 0), a2, va[0]);
            PG8_WAIT_V(8); PG8_WAIT_L(0); PG8_BAR; PG8_MMA(1, 0, At, B0); PG8_MMA(1, 1, At, B1); PG8_BAR; PG8_SCHED;
            PG8_LDB(B0, 1, 0); PG8_LDB(B1, 1, 1); PG8_SCHED; PG8_LDA(At, 1, 0); PG8_STAGE(PG8_SA(0, 1), a2 + hstepA, va[1]);
            PG8_WAIT_V(8); PG8_WAIT_L(0); PG8_BAR; PG8_MMA(0, 0, At, B0); PG8_MMA(0, 1, At, B1); PG8_BAR; PG8_SCHED;
            PG8_LDA(At, 1, 1); PG8_STAGE(PG8_SB(1, 0), b3, voffB); PG8_STAGE(PG8_SB(1, 1), b3 + hstep, voffB); PG8_STAGE(PG8_SA(1, 0), a3, va[0]);
            PG8_WAIT_V(8); PG8_WAIT_L(0); PG8_BAR; PG8_MMA(1, 0, At, B0); PG8_MMA(1, 1, At, B1); PG8_BAR; PG8_SCHED;
            } else {
            PG8_LDB(B0, 0, 0); PG8_SCHED; PG8_LDA(At, 0, 0); PG8_STAGE(PG8_SA(1, 1), a1 + hstep, voffA);
            PG8_WAIT_L(8); PG8_BAR; PG8_WAIT_L(0); PG8_MMA(0, 0, At, B0); PG8_BAR; PG8_SCHED;
            PG8_LDB(B1, 0, 1); PG8_STAGE(PG8_SB(0, 0), b2, voffB);
            PG8_BAR; PG8_WAIT_L(0); PG8_MMA(0, 1, At, B1); PG8_BAR;
            PG8_LDA(At, 0, 1); PG8_STAGE(PG8_SA(0, 0), a2, voffA);
            PG8_BAR; PG8_WAIT_L(0); PG8_MMA(1, 0, At, B0); PG8_BAR; PG8_SCHED;
            PG8_STAGE(PG8_SB(0, 1), b2 + hstep, voffB);
            PG8_WAIT_V(6); PG8_BAR; PG8_MMA(1, 1, At, B1); PG8_BAR;
            PG8_LDB(B0, 1, 0); PG8_SCHED; PG8_LDA(At, 1, 0); PG8_STAGE(PG8_SA(0, 1), a2 + hstep, voffA);
            PG8_WAIT_L(8); PG8_BAR; PG8_WAIT_L(0); PG8_MMA(0, 0, At, B0); PG8_BAR; PG8_SCHED;
            PG8_LDB(B1, 1, 1); PG8_STAGE(PG8_SB(1, 0), b3, voffB);
            PG8_BAR; PG8_WAIT_L(0); PG8_MMA(0, 1, At, B1); PG8_BAR;
            PG8_LDA(At, 1, 1); PG8_STAGE(PG8_SA(1, 0), a3, voffA);
            PG8_BAR; PG8_WAIT_L(0); PG8_MMA(1, 0, At, B0); PG8_BAR; PG8_SCHED;
            PG8_STAGE(PG8_SB(1, 1), b3 + hstep, voffB);
            PG8_WAIT_V(6); PG8_BAR; PG8_MMA(1, 1, At, B1); PG8_BAR;
            }
        }
        if constexpr (ALIGN_EPI) { if (wr == 0) PG8_BAR; }
        if constexpr (!Epi::AFTER_DRAIN) { int lq; asm volatile("v_mov_b32 %0, %1" : "=v"(lq) : "v"(lane)); E(acc, cur, wr, wc, lq & 15, lq >> 4); S.done(cur); }
        if (!has_next) break;
#pragma unroll
        for (int a = 0; a < 2; ++a)
#pragma unroll
            for (int b = 0; b < 2; ++b)
#pragma unroll
                for (int m = 0; m < 4; ++m)
#pragma unroll
                    for (int n = 0; n < 2; ++n) acc[a][b][m][n] = (f32x4){0.f, 0.f, 0.f, 0.f};
        cur = nxt; cA = nA; cB = nB; ++ui;
        if constexpr (ALIGN_EPI) { if (wr == 1) PG8_BAR; }
    }
    PG8_WAIT_V(0);
    if constexpr (!ALIGN_EPI) { if (wr == 0) PG8_BAR; }
    PG8_BAR;
    if constexpr (Epi::AFTER_DRAIN) { E.fused(acc, cur, wr, wc, fr, fq, lds, wid, lane); S.done(cur); }
#undef PG8_SA
#undef PG8_SB
#undef PG8_STAGE
#undef PG8_LDA
#undef PG8_GLOADH
#undef PG8_LDB
#undef PG8_MMA
#undef PG8_WAIT_V
#undef PG8_WAIT_L
#undef PG8_BAR
#undef PG8_SCHED
}
}

namespace attn {
constexpr int D = 128; constexpr float THR = 8.f; constexpr bool WSKIP = false;
constexpr float SCALE = 0.08838834764831845f;
constexpr int NW = 8, QBLK = 32, KVBLK = 64, QB = NW * QBLK;
constexpr int SHM_V = KVBLK * D * 2, SHM_K = KVBLK * D * 2;
constexpr int LDS_BYTES = 2 * SHM_V + 2 * SHM_K + NW * 64 * 4;

typedef short bf16x8 __attribute__((ext_vector_type(8)));
typedef short s16x4 __attribute__((ext_vector_type(4)));
typedef float f32x16 __attribute__((ext_vector_type(16)));
typedef float f32x4 __attribute__((ext_vector_type(4)));
typedef unsigned u32x4 __attribute__((ext_vector_type(4)));
template <class A, class Bt> struct same_t { static constexpr bool v = false; };
template <class A> struct same_t<A, A> { static constexpr bool v = true; };

__device__ __forceinline__ int opaque_tid() { int t; asm volatile("v_mov_b32 %0, %1" : "=v"(t) : "v"(threadIdx.x)); return t; }
#define KSWZ(row, colB) ((row) * 256 + ((colB) ^ (((row) & 7) << 4)))
#define SBAR() __builtin_amdgcn_sched_barrier(0)
__device__ __forceinline__ int v_st(int k, int c) { const int kk = (k & ~0xC) | ((k & 4) << 1) | ((k & 8) >> 1); return ((kk >> 3) * 4 + (c >> 5)) * 512 + ((kk & 7) * 32 + (c & 31)) * 2; }
__device__ __forceinline__ int v_rd_base(int lane) { return ((lane & 3) << 3) | (((lane >> 2) & 3) << 6) | (((lane >> 4) & 1) << 5) | (((lane >> 5) & 1) << 8); }
constexpr int v_rd_off(int d0, int ks, int half) { return d0 * 512 + ks * 4096 + half * 2048; }
__device__ __forceinline__ int crow(int r, int hi) { return (r & 3) + 8 * (r >> 2) + 4 * hi; }
__device__ __forceinline__ unsigned cvtpk(float lo, float hi) {
    unsigned r; asm volatile("v_cvt_pk_bf16_f32 %0, %1, %2" : "=v"(r) : "v"(lo), "v"(hi)); return r;
}
__device__ __forceinline__ bf16x8 pack8(f32x4 a, f32x4 b) {
    u32x4 w = {cvtpk(a[0], a[1]), cvtpk(a[2], a[3]), cvtpk(b[0], b[1]), cvtpk(b[2], b[3])};
    return *reinterpret_cast<bf16x8*>(&w);
}
template <class T> __device__ __forceinline__ bf16x8 load8(const T* p) {
    if constexpr (same_t<T, float>::v) { return pack8(*(const f32x4*)p, *(const f32x4*)(p + 4)); }
    else { return *reinterpret_cast<const bf16x8*>(p); }
}
__device__ __forceinline__ void mask_tile(f32x16& p0, f32x16& p1, int dq, unsigned W) {
    const float NEG = -__builtin_inff();
#pragma unroll
    for (int r = 0; r < 16; ++r) {
        const int c = (r & 3) + 8 * (r >> 2);
        if ((unsigned)(dq - c) >= W) p0[r] = NEG;
        if ((unsigned)(dq - c - 32) >= W) p1[r] = NEG;
    }
}
__device__ __forceinline__ void partialSM(f32x16& p0, f32x16& p1, float& m_reg, float& mn, float& alpha) {
    float pmax = p0[0]; for (int r = 1; r < 16; ++r) pmax = fmaxf(pmax, p0[r]); for (int r = 0; r < 16; ++r) pmax = fmaxf(pmax, p1[r]);
    { auto rr = __builtin_amdgcn_permlane32_swap(__float_as_uint(pmax), __float_as_uint(pmax), false, false);
      pmax = fmaxf(__uint_as_float(rr[0]), __uint_as_float(rr[1])); }
    constexpr float C2 = 1.4426950408889634f * SCALE;
    if (__builtin_expect(__all((pmax - m_reg) * SCALE <= THR), 1)) { mn = m_reg; alpha = 1.f; }
    else { mn = fmaxf(m_reg, pmax); alpha = __builtin_amdgcn_exp2f((m_reg - mn) * C2); m_reg = mn; }
    const float mnL = -mn * C2;
    for (int r = 0; r < 16; ++r) p0[r] = fmaf(p0[r], C2, mnL); for (int r = 0; r < 16; ++r) p1[r] = fmaf(p1[r], C2, mnL);
    for (int r = 0; r < 16; ++r) p0[r] = __builtin_amdgcn_exp2f(p0[r]);
}
__device__ __forceinline__ void finishSM(f32x16& p0, f32x16& p1, float alpha, float& l_reg, bf16x8& pa0, bf16x8& pa1, bf16x8& pa2, bf16x8& pa3) {
    for (int r = 0; r < 16; ++r) p1[r] = __builtin_amdgcn_exp2f(p1[r]);
    float ps = 0; for (int r = 0; r < 16; ++r) ps += p0[r]; for (int r = 0; r < 16; ++r) ps += p1[r];
    { auto rr = __builtin_amdgcn_permlane32_swap(__float_as_uint(ps), __float_as_uint(ps), false, false);
      ps = __uint_as_float(rr[0]) + __uint_as_float(rr[1]); }
    l_reg = l_reg * alpha + ps;
#define PK4(P, B_, OUT) do { unsigned a0 = cvtpk(P[B_+0], P[B_+1]), a1 = cvtpk(P[B_+2], P[B_+3]);                          \
        unsigned b0 = cvtpk(P[B_+4], P[B_+5]), b1 = cvtpk(P[B_+6], P[B_+7]);                                             \
        auto r0 = __builtin_amdgcn_permlane32_swap(a0, b0, false, false); auto r1 = __builtin_amdgcn_permlane32_swap(a1, b1, false, false); \
        u32x4 w = {r0[0], r1[0], r0[1], r1[1]}; OUT = *reinterpret_cast<bf16x8*>(&w); } while (0)
    PK4(p0, 0, pa0); PK4(p0, 8, pa1); PK4(p1, 0, pa2); PK4(p1, 8, pa3);
#undef PK4
}
template <int KB, bool SK>
__device__ __forceinline__ void qkt(f32x16& p0, f32x16& p1, const char* K_lds, int r32, int hi, const bf16x8* qr, bool act, const float* cbt) {
    if (SK && !act) { const float NEG = -__builtin_inff();
#pragma unroll
        for (int r = 0; r < 16; ++r) { p0[r] = NEG; p1[r] = NEG; } return; }
#pragma unroll
    for (int g = 0; g < 4; ++g) { const f32x4 b0 = *(const f32x4*)(cbt + 8 * g), b1 = *(const f32x4*)(cbt + 32 + 8 * g);
        p0[4 * g] = b0[0]; p0[4 * g + 1] = b0[1]; p0[4 * g + 2] = b0[2]; p0[4 * g + 3] = b0[3]; p1[4 * g] = b1[0]; p1[4 * g + 1] = b1[1]; p1[4 * g + 2] = b1[2]; p1[4 * g + 3] = b1[3]; }
    const char* kb[4];
#pragma unroll
    for (int dd = 0; dd < 4; ++dd) kb[dd] = K_lds + KB * SHM_K + KSWZ(r32, (dd * 16 + hi * 8) * 2);
#pragma unroll
    for (int d0 = 0; d0 < 8; ++d0) { const char* a = kb[d0 & 3] + (d0 >> 2) * 128;
        bf16x8 b0 = *reinterpret_cast<const bf16x8*>(a);
        bf16x8 b1 = *reinterpret_cast<const bf16x8*>(a + 32 * 256);
        p0 = __builtin_amdgcn_mfma_f32_32x32x16_bf16(b0, qr[d0], p0, 0, 0, 0);
        p1 = __builtin_amdgcn_mfma_f32_32x32x16_bf16(b1, qr[d0], p1, 0, 0, 0); }
}
template <int VB, bool SK>
__device__ __forceinline__ void pv_tile(f32x16* o, int vb0, bf16x8 pa0, bf16x8 pa1, bf16x8 pa2, bf16x8 pa3, bool act) {
    if (SK && !act) return;
#define TRRD(dst, off) asm volatile("ds_read_b64_tr_b16 %0, %1 offset:%2" : "=&v"(dst) : "v"(vb0), "i"(off) : "memory")
#define PV_D0(d0) do { s16x4 l0, l1, l2, l3, h0, h1, h2, h3; constexpr int b_ = VB * SHM_V + v_rd_off(d0, 0, 0);     \
        TRRD(l0, b_); TRRD(h0, b_ + 2048); TRRD(l1, b_ + 4096); TRRD(h1, b_ + 6144); TRRD(l2, b_ + 8192); TRRD(h2, b_ + 10240); TRRD(l3, b_ + 12288); TRRD(h3, b_ + 14336); \
        asm volatile("s_waitcnt lgkmcnt(0)" ::: "memory"); SBAR();                 \
        o[d0] = __builtin_amdgcn_mfma_f32_32x32x16_bf16(pa0, (bf16x8){l0[0], l0[1], l0[2], l0[3], h0[0], h0[1], h0[2], h0[3]}, o[d0], 0, 0, 0);   \
        o[d0] = __builtin_amdgcn_mfma_f32_32x32x16_bf16(pa1, (bf16x8){l1[0], l1[1], l1[2], l1[3], h1[0], h1[1], h1[2], h1[3]}, o[d0], 0, 0, 0);   \
        o[d0] = __builtin_amdgcn_mfma_f32_32x32x16_bf16(pa2, (bf16x8){l2[0], l2[1], l2[2], l2[3], h2[0], h2[1], h2[2], h2[3]}, o[d0], 0, 0, 0);   \
        o[d0] = __builtin_amdgcn_mfma_f32_32x32x16_bf16(pa3, (bf16x8){l3[0], l3[1], l3[2], l3[3], h3[0], h3[1], h3[2], h3[3]}, o[d0], 0, 0, 0); } while (0)
    PV_D0(0); PV_D0(1); PV_D0(2); PV_D0(3);
#undef PV_D0
#undef TRRD
}

template <class TIn, class TOut> struct BlockRef { const TIn* Q; const TIn* K; const TIn* V; TOut* O; const float* CB; int P0; int JL; };
template <class TIn> struct Seam {
    bf16x8 qr[8];
    bf16x8 st_v0, st_v1, st_k0, st_k1; f32x4 sf0, sf1, sf2, sf3;
    f32x4 tq[16];
};
__device__ __forceinline__ int swa_jlo(int P0, int W) { const int lowk = P0 - W + 1; return lowk > 0 ? lowk / KVBLK : 0; }
#define ROWK(p, k0, rr) ((p) + (size_t)((k0) + (rr)) * KP + sc)
#define ROWV(p, k0, rr) ((p) + (size_t)((k0) + (rr)) * VP + sc)
#define VMW() asm volatile("s_waitcnt vmcnt(0)" ::: "memory")
#define VMWN(n) asm volatile("s_waitcnt vmcnt(%0)" :: "i"(n) : "memory")
#define SLOAD_H(Kp, Vp, k0) do { S.st_v0 = load8<TIn>(ROWV(Vp, k0, sr)); S.st_v1 = load8<TIn>(ROWV(Vp, k0, 32 + sr));              \
                         S.st_k0 = load8<TIn>(ROWK(Kp, k0, sr)); S.st_k1 = load8<TIn>(ROWK(Kp, k0, 32 + sr)); } while (0)
#define SWRITE_HK(bf) do { *(bf16x8*)(K_lds + (bf) * SHM_K + kws) = S.st_k0; *(bf16x8*)(K_lds + (bf) * SHM_K + kws + 32 * 256) = S.st_k1; } while (0)
#define SWRITE_HV(bf) do { *(bf16x8*)(V_lds + (bf) * SHM_V + vst0) = S.st_v0; *(bf16x8*)(V_lds + (bf) * SHM_V + vst1) = S.st_v1; } while (0)
#define SWRITE_H(bf) do { SWRITE_HV(bf); SWRITE_HK(bf); } while (0)
#define SLOAD_F(p, k0) do { S.sf0 = *(const f32x4*)ROWK(p, k0, sr); S.sf1 = *(const f32x4*)(ROWK(p, k0, sr) + 4);                \
                            S.sf2 = *(const f32x4*)ROWK(p, k0, 32 + sr); S.sf3 = *(const f32x4*)(ROWK(p, k0, 32 + sr) + 4); } while (0)
#define SWRITE_KF(bf) do { *(bf16x8*)(K_lds + (bf) * SHM_K + kws) = pack8(S.sf0, S.sf1); *(bf16x8*)(K_lds + (bf) * SHM_K + kws + 32 * 256) = pack8(S.sf2, S.sf3); } while (0)
#define SWRITE_VF(bf) do { *(bf16x8*)(V_lds + (bf) * SHM_V + vst0) = pack8(S.sf0, S.sf1); *(bf16x8*)(V_lds + (bf) * SHM_V + vst1) = pack8(S.sf2, S.sf3); } while (0)
template <class TIn, class TOut, int QP, int KP, int VP, int OP>
__device__ __forceinline__ void causal_swa_prime(const BlockRef<TIn, TOut>& cur, int W, char* lds, Seam<TIn>& S) {
    constexpr bool F32 = same_t<TIn, float>::v;
    const int tid = opaque_tid(), wid = __builtin_amdgcn_readfirstlane(tid >> 6), lane = tid & 63, r32 = lane & 31, hi = lane >> 5;
    const int sr = tid >> 4, sc = (tid & 15) * 8, kws = KSWZ(sr, sc * 2); char* K_lds = lds + 2 * SHM_V;
    const int kb0 = cur.JL * KVBLK;
    for (int d0 = 0; d0 < 8; ++d0) S.qr[d0] = load8<TIn>(cur.Q + (size_t)(wid * QBLK + r32) * QP + d0 * 16 + hi * 8);
    if constexpr (F32) { SLOAD_F((const float*)cur.K, kb0); VMW(); SWRITE_KF(0); SBAR(); SLOAD_F((const float*)cur.V, kb0); }
    else { SLOAD_H(cur.K, cur.V, kb0); VMW(); SWRITE_HK(0); }
    __syncthreads();
}
template <class TIn, class TOut, int QP, int KP, int VP, int OP>
__device__ __forceinline__ void causal_swa_block(const BlockRef<TIn, TOut>& cur, const BlockRef<TIn, TOut>& nxt, int skv, int W, char* lds, Seam<TIn>& S) {
    constexpr bool F32 = same_t<TIn, float>::v;
    const int tid = opaque_tid(), wid = __builtin_amdgcn_readfirstlane(tid >> 6), lane = tid & 63, r32 = lane & 31, hi = lane >> 5;
    const int j_lo = cur.JL;
    int j_hi = (cur.P0 + QB - 1) / KVBLK + 1; if (j_hi > skv / KVBLK) j_hi = skv / KVBLK;
    const int NT = j_hi - j_lo;
    const int kbn = nxt.JL * KVBLK;
    const int qlo = cur.P0 + wid * QBLK, qm = qlo + r32 - 4 * hi;
    char* V_lds = lds; char* K_lds = lds + 2 * SHM_V;
    float* ws = (float*)(lds + 2 * SHM_V + 2 * SHM_K) + wid * 64; float* li_l = ws, * al_l = ws + 32;
    float m_reg = -1e30f, l_reg = 0; f32x16 o[4] = {};
    float* cbl_w = (float*)(lds + 2 * SHM_V + 2 * SHM_K + NW * 64 * 4);
    { const int n4 = (cur.P0 + QB) / 4; for (int i = 16 * cur.JL + tid; i < n4; i += 64 * NW) ((f32x4*)cbl_w)[i] = ((const f32x4*)cur.CB)[i]; }
    __syncthreads();
    const float* cbl = cbl_w + 4 * hi;
    const int sr = tid >> 4, sc = (tid & 15) * 8, vst0 = v_st(sr, sc), vst1 = v_st(32 + sr, sc), kws = KSWZ(sr, sc * 2);
    const int vb0 = (int)(uintptr_t)V_lds + v_rd_base(lane);
    const TIn* Kh = cur.K; const TIn* Vh = cur.V;
#define RESC(a) do { if (__any((a) < 1.f)) { if (hi == 0) al_l[r32] = (a); asm volatile("s_waitcnt lgkmcnt(0)" ::: "memory");              \
                     for (int d_ = 0; d_ < 4; ++d_) for (int r = 0; r < 16; ++r) o[d_][r] *= al_l[crow(r, hi)]; } } while (0)
#define KBASE(t) ((j_lo + (t)) * KVBLK)
#define ACT(t) (KBASE(t) <= qlo + QBLK - 1 && KBASE(t) + KVBLK - 1 >= qlo - W + 1)
#define MASKT(P0_, P1_, t) do { const int kb_ = KBASE(t); if ((!SK || ACT(t)) && (kb_ + KVBLK - 1 > qlo || kb_ <= qlo + QBLK - 1 - W)) mask_tile(P0_, P1_, qm - kb_, (unsigned)W); } while (0)
    constexpr int NQL = F32 ? 16 : 8;
    constexpr bool SK = WSKIP && !F32;
#define SEAM_K0() do { VMWN(NQL); if constexpr (F32) { SWRITE_KF(0); SBAR(); SLOAD_F((const float*)nxt.V, kbn); } else { SWRITE_HK(0); } SBAR(); } while (0)
    f32x16 pA0, pA1, pB0, pB1; float mnA, mnB, alA, alB; bf16x8 pa0, pa1, pa2, pa3;
    if constexpr (F32) { VMW(); SWRITE_VF(0); SBAR(); } else { SWRITE_HV(0); SBAR(); }
    if (NT > 1) { if constexpr (F32) SLOAD_F((const float*)Kh, KBASE(1)); else SLOAD_H(Kh, Vh, KBASE(1)); }
    SBAR(); qkt<0, SK>(pA0, pA1, K_lds, r32, hi, S.qr, ACT(0), cbl + KBASE(0));
    if constexpr (F32) { if (NT > 1) { VMW(); SWRITE_KF(1); SBAR(); SLOAD_F((const float*)Vh, KBASE(1)); } }
    MASKT(pA0, pA1, 0); partialSM(pA0, pA1, m_reg, mnA, alA);
    if (NT > 1) { VMW(); if constexpr (F32) { SWRITE_VF(1); SBAR(); if (NT > 2) SLOAD_F((const float*)Kh, KBASE(2)); } else SWRITE_H(1); }
    __syncthreads();
#define HALF_STEP(PX0, PX1, mnX, alX, PY0, PY1, alY, t, KB, VB, SB) do {                                                      \
        SBAR(); qkt<KB, SK>(PX0, PX1, K_lds, r32, hi, S.qr, ACT(t), cbl + KBASE(t));                                             \
        finishSM(PY0, PY1, alY, l_reg, pa0, pa1, pa2, pa3); SBAR();                                                           \
        if ((t) + 1 < NT) { if constexpr (F32) { VMW(); SWRITE_KF(SB); SBAR(); SLOAD_F((const float*)Vh, KBASE((t) + 1)); }  \
                            else { SLOAD_H(Kh, Vh, KBASE((t) + 1)); } SBAR(); }                                               \
        pv_tile<VB, SK>(o, vb0, pa0, pa1, pa2, pa3, ACT((t) - 1)); MASKT(PX0, PX1, (t)); partialSM(PX0, PX1, m_reg, mnX, alX);                                        \
        __syncthreads();                                                                                                      \
        if ((t) + 1 < NT) { VMW(); if constexpr (F32) { SWRITE_VF(SB); SBAR(); if ((t) + 2 < NT) SLOAD_F((const float*)Kh, KBASE((t) + 2)); } \
                            else { SWRITE_H(SB); } }                                                                          \
        RESC(alX); __syncthreads(); } while (0)
    for (int t = 1; t + 1 < NT; t += 2) {
        HALF_STEP(pB0, pB1, mnB, alB, pA0, pA1, alA, t, 1, 0, 0);
        HALF_STEP(pA0, pA1, mnA, alA, pB0, pB1, alB, t + 1, 0, 1, 1);
    }
    const bool even = (NT & 1) == 0;
    if (even) { SBAR(); qkt<1, SK>(pB0, pB1, K_lds, r32, hi, S.qr, ACT(NT - 1), cbl + KBASE(NT - 1)); SBAR(); }
#define QROW(e) (nxt.Q + (size_t)(wid * QBLK + r32) * QP + ((e) >> 1) * 16 + hi * 8 + ((e) & 1) * 4)
    if constexpr (F32) { SLOAD_F((const float*)nxt.K, kbn); SBAR();
#pragma unroll
        for (int e = 0; e < 8; ++e) S.tq[e] = *(const f32x4*)QROW(e); }
    else { SLOAD_H(nxt.K, nxt.V, kbn); SBAR();
#pragma unroll
        for (int d0 = 0; d0 < 8; ++d0) S.qr[d0] = load8<TIn>(nxt.Q + (size_t)(wid * QBLK + r32) * QP + d0 * 16 + hi * 8); }
    SBAR();
    finishSM(pA0, pA1, alA, l_reg, pa0, pa1, pa2, pa3); SBAR();
    if constexpr (F32) {
#pragma unroll
        for (int e = 8; e < 16; ++e) S.tq[e] = *(const f32x4*)QROW(e); SBAR(); }
#undef QROW
    pv_tile<0, SK>(o, vb0, pa0, pa1, pa2, pa3, ACT(even ? NT - 2 : NT - 1));
    if (even) { MASKT(pB0, pB1, NT - 1); partialSM(pB0, pB1, m_reg, mnB, alB); __syncthreads(); RESC(alB);
        finishSM(pB0, pB1, alB, l_reg, pa0, pa1, pa2, pa3); SBAR(); pv_tile<1, SK>(o, vb0, pa0, pa1, pa2, pa3, ACT(NT - 1)); }
    SBAR(); SEAM_K0();
    if (hi == 0) li_l[r32] = l_reg; asm volatile("s_waitcnt lgkmcnt(0)" ::: "memory");
    float rli[16];
#pragma unroll
    for (int r = 0; r < 16; ++r) rli[r] = __builtin_amdgcn_rcpf(li_l[crow(r, hi)]);
    TOut* Ow = cur.O + (size_t)(wid * QBLK) * OP;
#pragma unroll
    for (int r = 0; r < 16; ++r) { const int orow = crow(r, hi);
#pragma unroll
        for (int d0 = 0; d0 < 4; ++d0) { const float v = o[d0][r] * rli[r];
            if constexpr (same_t<TOut, float>::v) { Ow[(size_t)orow * OP + d0 * 32 + r32] = v; }
            else { const float vn = __shfl_xor(v, 1);
                   if ((r32 & 1) == 0) *(unsigned*)(Ow + (size_t)orow * OP + d0 * 32 + r32) = cvtpk(v, vn); } } }
    if constexpr (F32) {
#pragma unroll
        for (int d0 = 0; d0 < 8; ++d0) S.qr[d0] = pack8(S.tq[2 * d0], S.tq[2 * d0 + 1]); }
    __syncthreads();
#undef RESC
#undef KBASE
#undef ACT
#undef MASKT
#undef SEAM_K0
#undef HALF_STEP
}
#undef ROWK
#undef ROWV
#undef VMW
#undef VMWN
#undef SLOAD_H
#undef SWRITE_HK
#undef SWRITE_HV
#undef SWRITE_H
#undef SLOAD_F
#undef SWRITE_KF
#undef SWRITE_VF
}

#define XB_TMO      128
#define XB_XCNT(j)  (256  + 64 * (j))
#define XB_XSUB(j)  (1280 + 64 * (j))
#define XB_XGEN(j)  (2304 + 64 * (j))
#define XB_TOP      3328
#define XB_TOPGEN   3392
#define XCD_BAR_WORDS 3456
#define XB_SPIN_CAP (1u << 18)

__device__ __forceinline__ unsigned xb_ld(unsigned* p)              { return __hip_atomic_load(p, __ATOMIC_RELAXED, __HIP_MEMORY_SCOPE_AGENT); }
__device__ __forceinline__ unsigned xb_add(unsigned* p, unsigned v) { return __hip_atomic_fetch_add(p, v, __ATOMIC_RELAXED, __HIP_MEMORY_SCOPE_AGENT); }
__device__ __forceinline__ unsigned xb_xcc_id() { return (unsigned)__builtin_amdgcn_s_getreg((3 << 11) | 20) & 0xFu; }
#define XB_SPIN(cond, bar) do { unsigned _sp = 0; while (cond) { __builtin_amdgcn_s_sleep(1); \
    if ((++_sp & 255u) == 0u) { if (xb_ld(&(bar)[XB_TMO])) break; if (_sp > XB_SPIN_CAP) { atomicAdd(&(bar)[XB_TMO], 1u); break; } } } } while (0)

struct XcdBarrier {
    unsigned* bar; unsigned x;
    volatile LAS unsigned* st;
};

__device__ __forceinline__ XcdBarrier xcd_barrier_post(unsigned* bar, volatile LAS unsigned* st) {
    XcdBarrier b; b.bar = bar; b.x = xb_xcc_id(); b.st = st;
    if (threadIdx.x == 0) (void)xb_add(&bar[XB_XCNT(b.x)], 1u);
    return b;
}
__device__ __forceinline__ void xcd_barrier_complete(unsigned* bar, unsigned x, unsigned& nloc, unsigned& nx) {
    const unsigned G = gridDim.x * gridDim.y * gridDim.z;
    unsigned sum, cnt, mine, sp = 0u;
    for (;;) {
        sum = 0u; cnt = 0u; mine = 0u;
#pragma unroll
        for (unsigned j = 0; j < 16; ++j) { const unsigned c = xb_ld(&bar[XB_XCNT(j)]); sum += c; cnt += (c > 0u) ? 1u : 0u; mine = (j == x) ? c : mine; }
        if (sum == G) break;
        __builtin_amdgcn_s_sleep(1);
        if ((++sp & 255u) == 0u) { if (xb_ld(&bar[XB_TMO])) break; if (sp > XB_SPIN_CAP) { atomicAdd(&bar[XB_TMO], 1u); break; } }
    }
    nloc = mine > 0u ? mine : 1u; nx = cnt > 0u ? cnt : 1u;
}

__device__ __forceinline__ void xcd_barrier(const XcdBarrier& b) {
    asm volatile("s_waitcnt vmcnt(0)" ::: "memory");
    __syncthreads();
    if (threadIdx.x == 0) {
        unsigned* bar = b.bar;
        __builtin_amdgcn_s_waitcnt(0);
        unsigned nloc = b.st[0], nx = b.st[1];
        if (nloc == 0u) { xcd_barrier_complete(bar, b.x, nloc, nx); b.st[0] = nloc; b.st[1] = nx; }
        const unsigned old = xb_add(&bar[XB_XSUB(b.x)], 1u);
        const unsigned gen = old / nloc;
        if (old + 1u == (gen + 1u) * nloc) {
            __builtin_amdgcn_fence(__ATOMIC_RELEASE, "agent");
            asm volatile("s_waitcnt vmcnt(0)" ::: "memory");
            const unsigned og = xb_add(&bar[XB_TOP], 1u);
            const unsigned tg = og / nx;
            if (og + 1u == (tg + 1u) * nx) xb_add(&bar[XB_TOPGEN], 1u);
            else XB_SPIN(xb_ld(&bar[XB_TOPGEN]) == tg, bar);
            __builtin_amdgcn_fence(__ATOMIC_ACQUIRE, "agent");
            xb_add(&bar[XB_XGEN(b.x)], 1u);
            asm volatile("s_waitcnt vmcnt(0)" ::: "memory");
        } else {
            XB_SPIN(xb_ld(&bar[XB_XGEN(b.x)]) == gen, bar);
            __builtin_amdgcn_fence(__ATOMIC_ACQUIRE, "agent");
            asm volatile("s_waitcnt vmcnt(0)" ::: "memory");
        }
    }
    __syncthreads();
}

#ifndef MK_RANGES
#define MK_RANGES 0, 13
#endif
constexpr int NPHASE = 13;

constexpr size_t MiB = 1u << 20;
constexpr size_t al(size_t x) { return (x + 4095) & ~(size_t)4095; }
constexpr size_t WS_CTL = 0, CTL_ZERO_BYTES = 1 * MiB;
constexpr size_t WS_WINT = 1 * MiB;
constexpr size_t WS_WST  = WS_WINT + al((size_t)NPROJ * DM * 2);
constexpr size_t WS_WUFT = WS_WST + al(32 * DM * 2);
constexpr size_t WS_WUGT = WS_WUFT + al((size_t)DM * FW * 2);
constexpr size_t WS_WOT  = WS_WUGT + al((size_t)DM * FW * 2);
constexpr size_t WS_WRT  = WS_WOT + al((size_t)DM * DM * 2);
constexpr size_t WS_BGU  = WS_WRT + al(32 * DM * 2);
constexpr size_t WS_WGUT = WS_BGU + al((size_t)NE * 4096 * 4);
constexpr size_t WS_WDT  = WS_WGUT + al((size_t)NE * 4096 * DM * 2);
constexpr size_t WS_H1   = WS_WDT + al((size_t)NE * DM * DFF * 2);
constexpr size_t WS_SMALLP = WS_H1 + al((size_t)T * DM * 2);
constexpr size_t WS_PROJ = WS_SMALLP + al((size_t)T * 32 * 4);
constexpr size_t WS_QN   = WS_PROJ + al((size_t)T * NPROJ * 2);
constexpr size_t WS_KN   = WS_QN + al((size_t)T * FW * 2);
constexpr size_t WS_CB   = WS_KN + al((size_t)T * FW * 2);
constexpr size_t WS_GQKV = WS_CB + al((size_t)BATCH * NH * SEQ * 4);
constexpr size_t WS_GBETA = WS_GQKV + al((size_t)T * 3072 * 2);
constexpr size_t WS_GG   = WS_GBETA + al((size_t)T * 8 * 4);
constexpr size_t WS_GU   = WS_GG + al((size_t)T * 8 * 4);
constexpr size_t WS_GW   = WS_GU + al((size_t)NUNIT * 64 * 128 * 2);
constexpr size_t WS_GQD  = WS_GW + al((size_t)NUNIT * 64 * 128 * 2);
constexpr size_t WS_GKDT = WS_GQD + al((size_t)NUNIT * 64 * 128 * 2);
constexpr size_t WS_GATT = WS_GKDT + al((size_t)NUNIT * 64 * 128 * 2);
constexpr size_t WS_GGL  = WS_GATT + al((size_t)NUNIT * 64 * 64 * 2);
constexpr size_t WS_GO   = WS_GGL + al((size_t)NUNIT * 4);
constexpr size_t WS_YF   = WS_GO + al((size_t)T * FW * 4);
constexpr size_t WS_YG   = WS_YF + al((size_t)T * FW * 2);
constexpr size_t WS_TMP  = WS_YG + al((size_t)T * FW * 2);
constexpr size_t WS_MERGED = WS_TMP + al((size_t)T * DM * 4);
constexpr size_t WS_XN2  = WS_MERGED + al((size_t)T * DM * 2);
constexpr size_t WS_TOKE = WS_XN2 + al((size_t)T * DM * 2);
constexpr size_t WS_TOKW = WS_TOKE + al((size_t)T * 4 * 4);
constexpr size_t WS_TOKP = WS_TOKW + al((size_t)T * 4 * 4);
constexpr size_t WS_XS   = WS_TOKP + al((size_t)T * 4 * 4);
constexpr size_t WS_XN8  = WS_XS;
constexpr size_t WS_TOS  = WS_XS + (size_t)T * DM;
constexpr size_t WS_ACT  = WS_XS + al((size_t)MAXSLOT * DM * 2);
constexpr size_t WS_YB   = WS_ACT + al((size_t)MAXSLOT * DFF * 2);
constexpr size_t WS_H8   = WS_YB + al((size_t)MAXSLOT * DM * 2);
constexpr size_t WS_WIN8 = WS_H8 + al((size_t)T * DM);
constexpr size_t WS_VN   = WS_WIN8 + al((size_t)4096 * DM);
constexpr size_t WS_END  = WS_VN + al((size_t)T * FW * 2);
constexpr int CW_BAR = 4096;
constexpr int CW_CNT = 16384;
constexpr int CW_QP2 = 17408, CW_P2DONE = 19520;
constexpr int CW_QC = 18432, CW_P1DONE = 19456;
constexpr int CW_Q = 20480;
constexpr int CW_TS = 131072;
static_assert((CW_CNT + 64 * NE) * 4 <= (int)CTL_ZERO_BYTES, "CTL words inside the memset region");

constexpr int RING_OFF = 0, RING_BYTES = 151552;
constexpr int LDSCTL_OFF = RING_BYTES, MISC_OFF = LDSCTL_OFF + 320;
constexpr int TAB_OFF = MISC_OFF + 128;
constexpr int LDS_BYTES = 163840;
constexpr int TLD_OFF = TAB_OFF + 1536;
static_assert(TLD_OFF + 18 * 512 <= LDS_BYTES && 8 * 64 * 65 * 4 <= RING_BYTES, "LDS map");

struct Frame {
    LAS unsigned char* lds;
    volatile LAS unsigned* MISC;
    gu32* ctl;
    unsigned char* ws;
    int tid, lane, wave, G;
    const float* in[20]; float* out;
};
enum { I_X = 0, I_N1W, I_WIN, I_BFF, I_QNW, I_KNW, I_CONVW, I_ALOG, I_DTB, I_ONW, I_WUF, I_WUG, I_WO, I_N2W, I_WR, I_BR, I_WGU, I_BGU, I_WD, I_BD };
#define WSP(T_, off) ((T_*)(F.ws + (off)))

__device__ __forceinline__ void tr_item(const float* src, int ld, bf16* dst, int Kdst, int k0, int drow0, int mode, LAS float* scr, int lane) {
    f32x4 v[16];
    const float* p = src + (size_t)(lane >> 4) * ld + (lane & 15) * 4;
#pragma unroll
    for (int i = 0; i < 16; ++i) v[i] = __builtin_nontemporal_load((const f32x4*)(p + (size_t)(4 * i) * ld));
#pragma unroll
    for (int i = 0; i < 16; ++i) { LAS float* s = scr + (4 * i + (lane >> 4)) * 65 + (lane & 15) * 4; s[0] = v[i][0]; s[1] = v[i][1]; s[2] = v[i][2]; s[3] = v[i][3]; }
    LDS_WAIT(); asm volatile("" ::: "memory");
    const int c = lane & 7;
#pragma unroll
    for (int it = 0; it < 8; ++it) { const int ns = (lane >> 3) + 8 * it; const LAS float* s = scr + (8 * c) * 65 + ns;
        u32x4 o; o.x = cvt_pk_bf16(s[0 * 65], s[1 * 65]); o.y = cvt_pk_bf16(s[2 * 65], s[3 * 65]); o.z = cvt_pk_bf16(s[4 * 65], s[5 * 65]); o.w = cvt_pk_bf16(s[6 * 65], s[7 * 65]);
        int drow;
        if (mode == 0) drow = drow0 + ns; else { const int cs = drow0 + ns, j = cs >> 1; drow = 256 * (j >> 7) + 128 * (cs & 1) + (j & 127); }
        *(u32x4*)(dst + (size_t)drow * Kdst + k0 + 8 * c) = o; }
    LDS_WAIT(); asm volatile("" ::: "memory");
}
#ifndef CONV_PLAIN_LOADS
#define CONV_LOAD(p) __builtin_nontemporal_load(p)
#else
#define CONV_LOAD(p) (*(p))
#endif
__device__ __forceinline__ void tr8_load(f32x4 (&v)[16], const float* src, int ld, int hk, int lane) {
    const float* p = src + (size_t)(32 * hk + 16 * (lane >> 5)) * ld + (lane & 31) * 4;
#pragma unroll
    for (int i = 0; i < 16; ++i) v[i] = CONV_LOAD((const f32x4*)(p + (size_t)i * ld));
}
__device__ __forceinline__ void tr8_proc(const f32x4 (&v)[16], LAS unsigned char* tile, int hk, int lane) {
    const float k = pg8::W8_SCALE; const int nq = lane & 31, c = 2 * hk + (lane >> 5);
#pragma unroll
    for (int e = 0; e < 4; ++e) { u32x4 o;
#pragma unroll
        for (int m = 0; m < 4; ++m) o[m] = pg8::pk4_fp8(v[4 * m][e] * k, v[4 * m + 1][e] * k, v[4 * m + 2][e] * k, v[4 * m + 3][e] * k);
        *(LAS u32x4*)(tile + (4 * nq + e) * 128 + ((c ^ (nq & 7)) << 4)) = o; }
}
__device__ __forceinline__ void tr_item8(const float* src, int ld, unsigned char* dst, int Kdst, int k0, int drow0, int mode, LAS float* scr, int lane) {
    LAS unsigned char* tile = (LAS unsigned char*)scr; f32x4 va[16], vb[16];
    tr8_load(va, src, ld, 0, lane);
    tr8_load(vb, src, ld, 1, lane); tr8_proc(va, tile, 0, lane);
    tr8_load(va, src, ld, 2, lane); tr8_proc(vb, tile, 1, lane);
    tr8_load(vb, src, ld, 3, lane); tr8_proc(va, tile, 2, lane);
    tr8_proc(vb, tile, 3, lane);
    LDS_WAIT(); asm volatile("" ::: "memory");
    const int ch = lane & 7;
#pragma unroll
    for (int it = 0; it < 16; ++it) { const int row = (lane >> 3) + 8 * it; const u32x4 o = *(const LAS u32x4*)(tile + row * 128 + (ch << 4));
        int drow;
        if (mode == 0) drow = drow0 + row; else { const int cs = drow0 + row, j = cs >> 1; drow = 256 * (j >> 7) + 128 * (cs & 1) + (j & 127); }
        __builtin_nontemporal_store(o, (u32x4*)(dst + (size_t)drow * Kdst + k0 + ((ch ^ ((row >> 2) & 7)) << 4))); }
    LDS_WAIT(); asm volatile("" ::: "memory");
}
constexpr int KD = MOE_F8_DN ? 8 : 32, KG = MOE_F8_GU ? 8 : 32;
constexpr int CV3 = 16 * 32, CV4 = 16 * 32, CV5 = 32 * 32, CV6 = NE * KD * 32, CV7 = NE * KG * 64, NCONV_W = CV3 + CV4 + CV5 + CV6 + CV7, CONV_WPI = 8, NCONV_WG = NCONV_W / CONV_WPI;
static_assert(NCONV_W % (8 * CONV_WPI) == 0, "conversion items split over 8 queues of workgroup items");
__device__ __forceinline__ void conv_wave_item(Frame& F, int r, LAS float* scr) {
    const float* src; int ld, nn, Kdst; bf16* dst;
    if (r < CV3) { src = F.in[I_WUF]; ld = DM; nn = 32; dst = WSP(bf16, WS_WUFT); Kdst = DM; }
    else if ((r -= CV3) < CV4) { src = F.in[I_WUG]; ld = DM; nn = 32; dst = WSP(bf16, WS_WUFT) + FW; Kdst = DM; }
    else if ((r -= CV4) < CV5) { src = F.in[I_WO]; ld = DM; nn = 32; dst = WSP(bf16, WS_WOT); Kdst = DM; }
    else if ((r -= CV5) < CV6) { const int e = r / (KD * 32); r -= e * (KD * 32);
#if MOE_F8_DN
        const int kb = 2 * (r / 16), nb = 2 * (r % 16);
#else
        const int kb = (r / 32) * (32 / KD), nb = r % 32;
#endif
        const float* sp = F.in[I_WD] + (size_t)e * DFF * DM + (size_t)(64 * kb) * DM + 64 * nb;
#if MOE_F8_DN
        tr_item8(sp, DM, WSP(unsigned char, WS_WDT) + (size_t)e * DM * DFF, DFF, 64 * kb, 64 * nb, 0, scr, F.lane);
#else
        tr_item(sp, DM, WSP(bf16, WS_WDT) + (size_t)e * DM * DFF, DFF, 64 * kb, 64 * nb, 0, scr, F.lane);
#endif
        return; }
    else { r -= CV6; const int e = r / (KG * 64); r -= e * (KG * 64);
#if MOE_F8_GU
        const int kb = 2 * (r / 32), nb = 2 * (r % 32);
#else
        const int kb = (r / 64) * (32 / KG), nb = r % 64;
#endif
        const float* sp = F.in[I_WGU] + (size_t)e * DM * 4096 + (size_t)(64 * kb) * 4096 + 64 * nb;
#if MOE_F8_GU
        tr_item8(sp, 4096, WSP(unsigned char, WS_WGUT) + (size_t)e * 4096 * DM, DM, 64 * kb, 64 * nb, 1, scr, F.lane);
#else
        tr_item(sp, 4096, WSP(bf16, WS_WGUT) + (size_t)e * 4096 * DM, DM, 64 * kb, 64 * nb, 1, scr, F.lane);
#endif
        return; }
    const int kb = r / nn, nb = r - kb * nn;
    tr_item(src + (size_t)(64 * kb) * ld + 64 * nb, ld, dst, Kdst, 64 * kb, 64 * nb, 0, scr, F.lane);
}
struct P0Buf { f32x4 x[8]; };
__device__ __forceinline__ void p0_xload(P0Buf& B, const Frame& F, int m) { const f32x4* xr = (const f32x4*)(F.in[I_X] + (size_t)m * DM) + F.lane;
#pragma unroll
    for (int j = 0; j < 8; ++j) B.x[j] = xr[64 * j]; }
__device__ __forceinline__ void p0_xrow(const P0Buf& B, const Frame& F, int m) {
    const f32x4* nw = (const f32x4*)F.in[I_N1W] + F.lane; float ss = 0.f;
#pragma unroll
    for (int j = 0; j < 8; ++j) ss += (B.x[j][0] * B.x[j][0] + B.x[j][1] * B.x[j][1]) + (B.x[j][2] * B.x[j][2] + B.x[j][3] * B.x[j][3]);
    const float rs = rsqrtf(wave_sum(ss) * (1.f / DM) + RMS_EPS);
    u32x2* o8 = (u32x2*)(WSP(bf16, WS_H1) + (size_t)m * DM) + F.lane;
#pragma unroll
    for (int j = 0; j < 8; ++j) { const f32x4 w = nw[64 * j], v = B.x[j]; u32x2 o; o.x = cvt_pk_bf16(v[0] * rs * w[0], v[1] * rs * w[1]); o.y = cvt_pk_bf16(v[2] * rs * w[2], v[3] * rs * w[3]); o8[64 * j] = o;
#if GATES_F8
        ((unsigned*)(WSP(unsigned char, WS_H8) + (size_t)m * DM))[F.lane + 64 * j] = pg8::pk4_fp8(v[0] * rs * w[0], v[1] * rs * w[1], v[2] * rs * w[2], v[3] * rs * w[3]);
#endif
    }
}
__device__ __forceinline__ void p0_prologue(Frame& F) {
    LAS float* scr = (LAS float*)(F.lds + RING_OFF) + F.wave * (64 * 65);
    const int gw = blockIdx.x * NWAVES + F.wave, NGW = F.G * NWAVES;
    constexpr int C0 = 32 * 48, C1 = 32 * 64, C2 = 32 * 64;
    for (int it = gw; it < C0 + C1 + C2; it += NGW) {
        int r = it; const float* src; int nn, drow;
        if (r < C0) { src = F.in[I_WIN]; nn = 48; drow = 0; }
        else if ((r -= C0) < C1) { src = F.in[I_WIN] + 3080; nn = 64; drow = 3072; }
        else { r -= C1;
#if GATES_F8
            if (r >= 16 * 32) continue; { const int kb = r / 32, nb = r - kb * 32;
              tr_item8(F.in[I_WIN] + 7192 + (size_t)(128 * kb) * IN_COLS + 128 * nb, IN_COLS, WSP(unsigned char, WS_WIN8), DM, 128 * kb, GATES_SIG == 3 ? ((nb & 15) * 256 + (nb >> 4) * 128) : 128 * nb, 0, scr, F.lane); continue; }
#endif
            src = F.in[I_WIN] + 7192; nn = 64; drow = 7168; }
        const int kb = r / nn, nb = r - kb * nn;
        tr_item(src + (size_t)(64 * kb) * IN_COLS + 64 * nb, IN_COLS, WSP(bf16, WS_WINT), DM, 64 * kb, drow + 64 * nb, 0, scr, F.lane);
    }
#if !CONV_IN_P4
#ifndef CONV_WGS
#define CONV_WGS 256
#endif
    if ((int)blockIdx.x < CONV_WGS) for (int it = gw; it < NCONV_W; it += CONV_WGS * NWAVES) conv_wave_item(F, it, scr);
#endif
    const int gt = blockIdx.x * (NWAVES * 64) + F.tid, NGT = F.G * NWAVES * 64;
    { bf16* wst = WSP(bf16, WS_WST); const float* win = F.in[I_WIN];
      for (int i = gt; i < 32 * DM; i += NGT) { const int row = i / DM, d = i - row * DM; float v = 0.f;
          if (row < 24) { const int col = row < 8 ? 3072 + row : (row < 16 ? 7176 + (row - 8) : 7184 + (row - 16)); v = win[(size_t)d * IN_COLS + col]; }
          wst[i] = f2bf(v); } }
    { bf16* wrt = WSP(bf16, WS_WRT); const float* wr = F.in[I_WR];
      for (int i = gt; i < 32 * DM; i += NGT) { const int e = i / DM, d = i - e * DM; wrt[i] = f2bf(wr[d * NE + e]); } }
    { float* bgu = WSP(float, WS_BGU); const float* b = F.in[I_BGU];
      for (int i = gt; i < NE * 4096; i += NGT) { const int e = i >> 12, c = i & 4095, pn = c >> 8, bj = (c >> 7) & 1, x = c & 127; bgu[i] = b[(size_t)e * 4096 + 2 * (128 * pn + x) + bj]; } }
    for (int m = gw; m < T; m += NGW) { P0Buf A; p0_xload(A, F, m); p0_xrow(A, F, m); }
}

template <class Post>
__device__ __forceinline__ void skinny32(Frame& F, const bf16* A, const bf16* Bt, const Post& post) {
    LAS float* red = (LAS float*)(F.lds + RING_OFF); LAS float* fin = red + 8 * 64 * 33;
    const int c = F.lane & 31, hi = F.lane >> 5, w = F.wave;
    for (int tile = blockIdx.x; tile < T / 64; tile += F.G) {
        const int row0 = tile * 64;
        f32x16 acc0 = {}, acc1 = {};
        const bf16* bp = Bt + (size_t)c * DM + 256 * w + 8 * hi; const bf16* ap = A + (size_t)(row0 + c) * DM + 256 * w + 8 * hi;
#pragma unroll 8
        for (int s = 0; s < 16; ++s) { const bf16x8 b = *(const bf16x8*)(bp + 16 * s), a0 = *(const bf16x8*)(ap + 16 * s), a1 = *(const bf16x8*)(ap + (size_t)32 * DM + 16 * s);
            acc0 = __builtin_amdgcn_mfma_f32_32x32x16_bf16(a0, b, acc0, 0, 0, 0); acc1 = __builtin_amdgcn_mfma_f32_32x32x16_bf16(a1, b, acc1, 0, 0, 0); }
#pragma unroll
        for (int r = 0; r < 16; ++r) { red[(w * 64 + crow(r, hi)) * 33 + c] = acc0[r]; red[(w * 64 + 32 + crow(r, hi)) * 33 + c] = acc1[r]; }
        __syncthreads();
#pragma unroll
        for (int q = 0; q < 4; ++q) { const int idx = F.tid + 512 * q, tok = idx >> 5, col = idx & 31; float s = 0.f;
#pragma unroll
            for (int ww = 0; ww < 8; ++ww) s += red[(ww * 64 + tok) * 33 + col];
            fin[tok * 33 + col] = s; }
        __syncthreads();
        post(row0, fin);
        __syncthreads();
    }
}
__device__ __forceinline__ float log_sigmoid(float f) { return fminf(f, 0.f) - log1p_small(__expf(-fabsf(f))); }
struct PostSmall { float* out; int tid; const float* bff; float* ts;
    __device__ __forceinline__ void operator()(int row0, const LAS float* fin) const {
#pragma unroll
        for (int q = 0; q < 4; ++q) { const int idx = tid + 512 * q, tok = idx >> 5, col = idx & 31; out[(size_t)(row0 + tok) * 32 + col] = fin[tok * 33 + col]; }
        { const int h = tid >> 6, ln = tid & 63; const float s = wave_sum(log_sigmoid(fin[ln * 33 + h] + bff[h])); if (ln == 0) ts[(row0 >> 6) * 8 + h] = s; } }
};

__device__ __forceinline__ void p2_qknorm(Frame& F, int bid) {
    const int gw = bid * NWAVES + F.wave, NGW = 256 * NWAVES; const bf16* proj = WSP(bf16, WS_PROJ);
    const int cq = 8 * F.lane; const f32x4 wq0 = *(const f32x4*)(F.in[I_QNW] + (cq & 127)), wq1 = *(const f32x4*)(F.in[I_QNW] + (cq & 127) + 4), wk0 = *(const f32x4*)(F.in[I_KNW] + (cq & 127)), wk1 = *(const f32x4*)(F.in[I_KNW] + (cq & 127) + 4);
#pragma unroll 1
    for (int m0 = gw; m0 < T; m0 += 4 * NGW) { u32x4 v[4][4];
#pragma unroll
        for (int t = 0; t < 4; ++t) { const bf16* p = proj + (size_t)(m0 + t * NGW) * NPROJ + cq; v[t][0] = *(const u32x4*)(p + PC_FQ); v[t][1] = *(const u32x4*)(p + PC_FQ + 512); v[t][2] = *(const u32x4*)(p + PC_FK); v[t][3] = *(const u32x4*)(p + PC_FK + 512); }
#pragma unroll
        for (int t = 0; t < 4; ++t)
#pragma unroll
            for (int q = 0; q < 4; ++q) { f32x4 a, b; pg8::unpack8(v[t][q], a, b);
                float ss = (a[0] * a[0] + a[1] * a[1]) + (a[2] * a[2] + a[3] * a[3]) + (b[0] * b[0] + b[1] * b[1]) + (b[2] * b[2] + b[3] * b[3]);
                ss = sum16_dpp(ss);
                const float rs = rsqrtf(ss * (1.f / HD) + RMS_EPS);
                *(u32x4*)(WSP(bf16, q < 2 ? WS_QN : WS_KN) + (size_t)(m0 + t * NGW) * FW + cq + 512 * (q & 1)) = pg8::pack8(a * rs * (q < 2 ? wq0 : wk0), b * rs * (q < 2 ? wq1 : wk1)); }
    }
}
__device__ __forceinline__ void p2_cb_tile(Frame& F, int bid) {
    const float* ts = (const float*)(F.ctl + CW_TS);
    for (int tile = bid; tile < T / 64; tile += 256) { const int b = tile >> 7, tl = tile & 127, h = F.wave, ln = F.lane;
        float v = log_sigmoid(WSP(float, WS_SMALLP)[(size_t)(tile * 64 + ln) * 32 + h] + F.in[I_BFF][h]);
#pragma unroll
        for (int o = 1; o < 64; o <<= 1) { const float t = __shfl_up(v, o); if (ln >= o) v += t; }
        float pre = (ln < tl ? ts[(b * 128 + ln) * 8 + h] : 0.f) + (64 + ln < tl ? ts[(b * 128 + 64 + ln) * 8 + h] : 0.f);
        pre = wave_sum(pre);
        WSP(float, WS_CB)[(size_t)(b * NH + h) * SEQ + tl * 64 + ln] = -(pre + v) * 11.313708498984761f; }
}
__device__ __forceinline__ void p2_cbscan(Frame& F, int bid) {
    LAS float* wt = (LAS float*)(F.lds + RING_OFF);
    for (int bh = bid; bh < BATCH * NH; bh += 256) {
        const int b = bh >> 3, h = bh & 7; const float* sp = WSP(float, WS_SMALLP) + (size_t)(b * SEQ + 16 * F.tid) * 32 + h; const float bf = F.in[I_BFF][h];
        float ls[16], run = 0.f;
#pragma unroll
        for (int i = 0; i < 16; ++i) { run += log_sigmoid(sp[i * 32] + bf); ls[i] = run; }
        float v = run;
#pragma unroll
        for (int o = 1; o < 64; o <<= 1) { const float t = __shfl_up(v, o); if (F.lane >= o) v += t; }
        if (F.lane == 63) wt[F.wave] = v;
        __syncthreads();
        float pre = v - run;
        for (int ww = 0; ww < F.wave; ++ww) pre += wt[ww];
        float* cb = WSP(float, WS_CB) + (size_t)bh * SEQ + 16 * F.tid;
#pragma unroll
        for (int i = 0; i < 16; i += 4) *(f32x4*)(cb + i) = (f32x4){-(pre + ls[i]) * 11.313708498984761f, -(pre + ls[i + 1]) * 11.313708498984761f, -(pre + ls[i + 2]) * 11.313708498984761f, -(pre + ls[i + 3]) * 11.313708498984761f};
        __syncthreads();
    }
}

typedef attn::BlockRef<bf16, bf16> ABlock;
__device__ __forceinline__ ABlock attn_ref(Frame& F, int bh, int qb, int jl) {
    const int b = bh >> 3, h = bh & 7; const size_t row0 = (size_t)b * SEQ + (size_t)qb * 256;
    ABlock r; r.Q = WSP(bf16, WS_QN) + row0 * FW + h * HD; r.O = WSP(bf16, WS_YF) + row0 * DM + h * HD;
    r.K = WSP(bf16, WS_KN) + (size_t)b * SEQ * FW + h * HD; r.V = WSP(bf16, WS_VN) + (size_t)b * SEQ * FW + h * HD;
    r.CB = WSP(float, WS_CB) + (size_t)bh * SEQ; r.P0 = qb * 256; r.JL = jl; return r;
}
__device__ __forceinline__ int dequeue(Frame& F, int head_word, int limit, int stop_word = -1, unsigned stop_at = 0u) {
    __syncthreads();
    if (F.wave == 0) { const int myx = (int)xb_xcc_id() & 7; int ln; asm volatile("v_mov_b32 %0, %1" : "=v"(ln) : "v"(F.lane));
        unsigned hv = limit; if (ln < 8) hv = __hip_atomic_load((unsigned*)(F.ctl + head_word + 64 * ln), __ATOMIC_RELAXED, __HIP_MEMORY_SCOPE_AGENT);
        unsigned long long live = __ballot(ln < 8 && hv < (unsigned)limit);
        if (stop_word >= 0) { const unsigned sv = __hip_atomic_load((unsigned*)(F.ctl + stop_word), __ATOMIC_RELAXED, __HIP_MEMORY_SCOPE_AGENT); if (__builtin_amdgcn_readfirstlane(sv) >= stop_at) live = 0ull; }
        if (ln == 0) { int item = -1;
            for (int k = 0; k < 8 && item < 0; ++k) { const int qi = (myx + k) & 7; if (!((live >> qi) & 1ull)) continue;
                const unsigned idx = __hip_atomic_fetch_add((unsigned*)(F.ctl + head_word + 64 * qi), 1u, __ATOMIC_RELAXED, __HIP_MEMORY_SCOPE_AGENT);
                if (idx < (unsigned)limit) item = qi * limit + (int)idx; }
            F.MISC[16] = (unsigned)item; }
    }
    __syncthreads();
    return (int)F.MISC[16];
}
__device__ __forceinline__ void p4_attention(Frame& F, char* lds, int qword) {
    constexpr int W = 1 << 30;
    float th;
    { const float* wq = F.in[I_QNW]; const float* wk = F.in[I_KNW]; float mq = fmaxf(fabsf(wq[F.lane]), fabsf(wq[F.lane + 64])), mk = fmaxf(fabsf(wk[F.lane]), fabsf(wk[F.lane + 64]));
#pragma unroll
      for (int o = 1; o < 64; o <<= 1) { mq = fmaxf(mq, __shfl_xor(mq, o)); mk = fmaxf(mk, __shfl_xor(mk, o)); }
      th = 11.313708498984761f * (2.f * 11.313708498984761f * mq * mk + 30.f);
      th = __builtin_bit_cast(float, __builtin_amdgcn_readfirstlane(__builtin_bit_cast(int, th))); }
    for (;;) {
        const int it = dequeue(F, qword, 64); if (it < 0) break;
        const int xq = it >> 6, i = it & 63, bh = 2 * xq + (i & 1), qb = 31 - (i >> 1);
        int jl;
        { int ln; asm volatile("v_mov_b32 %0, %1" : "=v"(ln) : "v"(F.lane)); const float* cb = WSP(float, WS_CB) + (size_t)bh * SEQ; const int nt0 = qb * 4;
          const float c0 = cb[qb * 256]; const bool s0 = ln < nt0 && (c0 - cb[64 * ln + 63] >= th), s1 = ln + 64 < nt0 && (c0 - cb[64 * (ln + 64) + 63] >= th);
          const unsigned long long b0 = __ballot(s0), b1 = __ballot(s1);
          jl = (~b0 != 0ull) ? __builtin_ctzll(~b0) : 64 + ((~b1 != 0ull) ? __builtin_ctzll(~b1) : 64); if (jl > nt0) jl = nt0; jl = __builtin_amdgcn_readfirstlane(jl); }
        const ABlock cur = attn_ref(F, bh, qb, jl); attn::Seam<bf16> S;
        attn::causal_swa_prime<bf16, bf16, FW, FW, FW, DM>(cur, W, lds, S);
        attn::causal_swa_block<bf16, bf16, FW, FW, FW, DM>(cur, cur, SEQ, W, lds, S);
    }
}
__device__ __forceinline__ void p4_conversion(Frame& F) {
    LAS float* scr = (LAS float*)(F.lds + RING_OFF) + F.wave * (64 * 65);
    for (;;) { const int it = dequeue(F, CW_QC, NCONV_WG / 8); if (it < 0) break;
#pragma unroll 1
        for (int j = 0; j < CONV_WPI / 8; ++j) conv_wave_item(F, CONV_WPI * it + 8 * j + F.wave, scr); }
}
#if HAVE_GDN
__device__ __forceinline__ float softplusf_(float x) { return fmaxf(x, 0.f) + log1p_small(__expf(-fabsf(x))); }
__device__ __forceinline__ float siluf_(float x) { return x * sigmoidf_(x); }
__device__ __forceinline__ void p2_gdn_elem(Frame& F) {
    const int gw = blockIdx.x * NWAVES + F.wave, NGW = F.G * NWAVES; const bf16* proj = WSP(bf16, WS_PROJ) + PC_GQKV; bf16* dst = WSP(bf16, WS_GQKV); const float* cw = F.in[I_CONVW];
    for (int run = gw; run < T / 8; run += NGW) {
        const int t0 = run * 8, tl = t0 & (SEQ - 1);
#pragma unroll 1
        for (int j = 0; j < 6; ++j) { const int ch = 512 * j + 8 * F.lane;
            f32x4 w[4][2];
#pragma unroll
            for (int i = 0; i < 4; ++i) { w[i][0] = *(const f32x4*)(cw + i * 3072 + ch); w[i][1] = *(const f32x4*)(cw + i * 3072 + ch + 4); }
            f32x4 xa[11][2];
#pragma unroll
            for (int r = 0; r < 11; ++r) { if (tl + r - 3 >= 0) pg8::unpack8(*(const u32x4*)(proj + (size_t)(t0 + r - 3) * NPROJ + ch), xa[r][0], xa[r][1]); else { xa[r][0] = (f32x4){0.f, 0.f, 0.f, 0.f}; xa[r][1] = xa[r][0]; } }
#pragma unroll
            for (int t = 0; t < 8; ++t) { f32x4 a = w[0][0] * xa[t][0] + w[1][0] * xa[t + 1][0] + w[2][0] * xa[t + 2][0] + w[3][0] * xa[t + 3][0], b = w[0][1] * xa[t][1] + w[1][1] * xa[t + 1][1] + w[2][1] * xa[t + 2][1] + w[3][1] * xa[t + 3][1];
#pragma unroll
                for (int e = 0; e < 4; ++e) { a[e] = siluf_(a[e]); b[e] = siluf_(b[e]); }
                if (j < 4) { float ss = (a[0] * a[0] + a[1] * a[1]) + (a[2] * a[2] + a[3] * a[3]) + (b[0] * b[0] + b[1] * b[1]) + (b[2] * b[2] + b[3] * b[3]);
                    ss += __shfl_xor(ss, 1); ss += __shfl_xor(ss, 2); ss += __shfl_xor(ss, 4); ss += __shfl_xor(ss, 8);
                    const float rs = rsqrtf(ss + RMS_EPS); a = a * rs; b = b * rs; }
                *(u32x4*)(dst + (size_t)(t0 + t) * 3072 + ch) = pg8::pack8(a, b); }
        }
        { const int t = t0 + (F.lane >> 3), h = F.lane & 7; const float* sp = WSP(float, WS_SMALLP) + (size_t)t * 32;
          WSP(float, WS_GBETA)[(size_t)t * 8 + h] = sigmoidf_(sp[8 + h]);
          WSP(float, WS_GG)[(size_t)t * 8 + h] = -__expf(F.in[I_ALOG][h]) * softplusf_(sp[16 + h] + F.in[I_DTB][h]); }
    }
}
constexpr int GP_REG = 0, GP_REGB = 9216, GP_VEC = 73728, GP_VECB = 768, GP_TILE = 79872, GP_TILEB = 17408;
static_assert(GP_TILE + 4 * GP_TILEB <= RING_BYTES, "prep LDS");
__device__ __forceinline__ constexpr int offL(int i) { const int g = (i + 3) >> 2; return 8 * g * (g - 1) + 4 * g * (i - 4 * g + 3); }
__device__ __forceinline__ constexpr int offT(int i) { const int G = i >> 3; return 32 * G * (G + 1) + 8 * (G + 1) * (i - 8 * G); }
struct PrepRegs { u32x4 a[4][4], b[4][4]; };
__device__ __forceinline__ void prep_load(PrepRegs& R, const unsigned char* ws, int u, int tg, int sa, int sb) {
    const int n = u & (NCHUNK - 1), bh = u >> 7, h = bh & 7, b = bh >> 3; const bf16* src = (const bf16*)(ws + WS_PROJ) + ((size_t)b * SEQ + (size_t)n * GCH) * NPROJ + PC_GQKV + h * HD;
#pragma unroll
    for (int i = 0; i < 4; ++i) { const int id = tg + 256 * i, row = id >> 4, cc = id & 15;
#pragma unroll
        for (int tp = 0; tp < 4; ++tp) { const int rr = row - 3 + tp;
            if (n * GCH + rr >= 0) { const int ro = rr * NPROJ + cc * 8; R.a[i][tp] = *(const u32x4*)(src + ro + sa * 1024); R.b[i][tp] = *(const u32x4*)(src + ro + sb * 1024); }
            else { R.a[i][tp] = (u32x4){0u, 0u, 0u, 0u}; R.b[i][tp] = R.a[i][tp]; } } }
}
__device__ __forceinline__ void prep_conv(const u32x4 (&x)[4], const f32x4 (&w)[4][2], bool norm, LAS bf16* dst) {
    f32x4 a = {0.f, 0.f, 0.f, 0.f}, b = a;
#pragma unroll
    for (int tp = 0; tp < 4; ++tp) { f32x4 x0, x1; pg8::unpack8(x[tp], x0, x1); a += w[tp][0] * x0; b += w[tp][1] * x1; }
#pragma unroll
    for (int e = 0; e < 4; ++e) { a[e] = siluf_(a[e]); b[e] = siluf_(b[e]); }
    float ss = (a[0] * a[0] + a[1] * a[1]) + (a[2] * a[2] + a[3] * a[3]) + (b[0] * b[0] + b[1] * b[1]) + (b[2] * b[2] + b[3] * b[3]);
    ss = sum16_dpp(ss);
    if (norm) { const float rs = rsqrtf(ss + RMS_EPS); a = a * rs; b = b * rs; }
    *(LAS u32x4*)dst = pg8::pack8(a, b);
}
__device__ __forceinline__ void prep_write(const PrepRegs& R, LAS bf16* ta, LAS bf16* tb, int tg, const float* cw, int h, int sa, int sb) {
    const int cc = tg & 15;
    { f32x4 w[4][2];
#pragma unroll
      for (int tp = 0; tp < 4; ++tp) { const float* p = cw + tp * 3072 + sa * 1024 + h * HD + cc * 8; w[tp][0] = *(const f32x4*)p; w[tp][1] = *(const f32x4*)(p + 4); }
#pragma unroll
      for (int i = 0; i < 4; ++i) prep_conv(R.a[i], w, sa < 2, ta + ((tg + 256 * i) >> 4) * 136 + cc * 8);
      asm volatile("" ::: "memory"); }
    { f32x4 w[4][2];
#pragma unroll
      for (int tp = 0; tp < 4; ++tp) { const float* p = cw + tp * 3072 + sb * 1024 + h * HD + cc * 8; w[tp][0] = *(const f32x4*)p; w[tp][1] = *(const f32x4*)(p + 4); }
#pragma unroll
      for (int i = 0; i < 4; ++i) prep_conv(R.b[i], w, sb < 2, tb + ((tg + 256 * i) >> 4) * 136 + cc * 8); }
}
__device__ __forceinline__ void p3_gdn_prep(Frame& F, int bid) {
    LAS unsigned char* L0 = F.lds + RING_OFF;
    const int w = F.wave, g = w >> 2, wg = w & 3, tg = F.tid & 255; constexpr float SCQ = 0.08838834764831845f;
    LAS bf16* T0 = (LAS bf16*)(L0 + GP_TILE + 2 * g * GP_TILEB); LAS bf16* Kt = (LAS bf16*)(L0 + GP_TILE + (2 * g + 1) * GP_TILEB);
    { const int u = bid + 256 * w, n = u & (NCHUNK - 1), bh = u >> 7, h = bh & 7, b = bh >> 3; const int ln = F.lane;
        const float* sp = WSP(float, WS_SMALLP) + ((size_t)b * SEQ + (size_t)n * GCH + ln) * 32; float gg = -__expf(F.in[I_ALOG][h]) * softplusf_(sp[16 + h] + F.in[I_DTB][h]); const float bt = sigmoidf_(sp[8 + h]);
#pragma unroll
        for (int o = 1; o < 64; o <<= 1) { const float t = __shfl_up(gg, o); if (ln >= o) gg += t; }
        LAS float* gcv = (LAS float*)(L0 + GP_VEC + w * GP_VECB); gcv[ln] = gg; gcv[64 + ln] = bt; gcv[128 + ln] = __expf(gg); }
    { int tgA; asm volatile("v_mov_b32 %0, %1" : "=v"(tgA) : "v"(tg));
      PrepRegs R; prep_load(R, F.ws, bid + 256 * g, tgA, 0, 1);
      for (int up = 0; up < 4; ++up) { const int ui = 2 * up + g, u = bid + 256 * ui;
        int ln; asm volatile("v_mov_b32 %0, %1" : "=v"(ln) : "v"(F.lane));
        const int c = ln & 31, hi = ln >> 5; const int h = (u >> 7) & 7;
        int tgs; asm volatile("v_mov_b32 %0, %1" : "=v"(tgs) : "v"(tg));
        LAS float* Lr = (LAS float*)(L0 + GP_REG + ui * GP_REGB); const LAS float* gcv = (const LAS float*)(L0 + GP_VEC + ui * GP_VECB); const LAS float* btv = gcv + 64; const LAS float* egv = gcv + 128;
        LAS bf16* Qt = T0;
        prep_write(R, Qt, Kt, tgs, F.in[I_CONVW], h, 0, 1);
        if (up + 1 < 4) prep_load(R, F.ws, u + 512, tgs, 0, 1);
        __syncthreads();
#pragma unroll
        for (int jj = 0; jj < 2; ++jj) { const int job = wg + 4 * jj; if (job < 6) { const int kind = job >= 3, tl = job - 3 * kind, rbi = tl > 0, rbj = tl > 1; const LAS bf16* X = kind ? Qt : Kt;
            f32x16 acc = {};
#pragma unroll
            for (int s = 0; s < 8; ++s) { const bf16x8 a = *(const LAS bf16x8*)(X + (32 * rbi + c) * 136 + 16 * s + 8 * hi), bb = *(const LAS bf16x8*)(Kt + (32 * rbj + c) * 136 + 16 * s + 8 * hi);
                acc = __builtin_amdgcn_mfma_f32_32x32x16_bf16(a, bb, acc, 0, 0, 0); }
            const int j = 32 * rbj + c; const float gj = gcv[j];
#pragma unroll
            for (int r = 0; r < 16; ++r) { const int i = 32 * rbi + crow(r, hi); const float dec = __expf(fminf(gcv[i] - gj, 0.f));
                if (kind == 0) { const int g4 = (i + 3) >> 2; if (j < 4 * g4) Lr[8 * g4 * (g4 - 1) + 4 * g4 * (i - 4 * g4 + 3) + j] = (i > j) ? btv[i] * acc[r] * dec : 0.f; }
                else WSP(bf16, WS_GATT)[(size_t)u * 4096 + i * 64 + j] = f2bf((i >= j) ? acc[r] * SCQ * dec : 0.f); } } }
        if (wg == 2) { for (int i = ln; i < 32 * 32; i += 64) WSP(bf16, WS_GATT)[(size_t)u * 4096 + (i >> 5) * 64 + 32 + (i & 31)] = 0; }
        if (wg == 3 && ln == 0) WSP(float, WS_GGL)[u] = egv[63];
        { const float gl = gcv[63];
#pragma unroll
          for (int i2 = 0; i2 < 4; ++i2) { const int id = tgs + 256 * i2, row = id >> 4, cc = id & 15; f32x4 a, bq; pg8::unpack8(*(const LAS u32x4*)(Qt + row * 136 + cc * 8), a, bq); const float sc = SCQ * egv[row];
              *(u32x4*)(WSP(bf16, WS_GQD) + (size_t)u * 8192 + row * 128 + cc * 8) = pg8::pack8(a * sc, bq * sc); }
#pragma unroll
          for (int i2 = 0; i2 < 4; ++i2) { const int id = tgs + 256 * i2, d = id >> 3, i0 = (id & 7) * 8; float v[8];
#pragma unroll
              for (int e = 0; e < 8; ++e) v[e] = bf2f(Kt[(i0 + e) * 136 + d]) * __expf(gl - gcv[i0 + e]);
              u32x4 o; o.x = cvt_pk_bf16(v[0], v[1]); o.y = cvt_pk_bf16(v[2], v[3]); o.z = cvt_pk_bf16(v[4], v[5]); o.w = cvt_pk_bf16(v[6], v[7]);
              *(u32x4*)(WSP(bf16, WS_GKDT) + (size_t)u * 8192 + d * 64 + i0) = o; } }
        __syncthreads();
      } }
    { int cl; asm volatile("v_mov_b32 %0, %1" : "=v"(cl) : "v"(F.lane)); int vz; asm volatile("v_mov_b32 %0, 0" : "=v"(vz));
        const LAS float* Lz = (const LAS float*)(L0 + GP_REG + w * GP_REGB) + vz; const LAS float* gcv = (const LAS float*)(L0 + GP_VEC + w * GP_VECB);
        float t[64];
#pragma unroll
        for (int i = 0; i < 64; ++i) { float s0 = (i == cl) ? 1.f : 0.f, s1 = 0.f, s2 = 0.f, s3 = 0.f;
#pragma unroll
            for (int j4 = 0; j4 < (i + 3) / 4; ++j4) { const f32x4 l = *(const LAS f32x4*)(Lz + offL(i > 0 ? i : 1) + 4 * j4);
                if (4 * j4 + 0 < i) s0 -= l[0] * t[4 * j4 + 0]; if (4 * j4 + 1 < i) s1 -= l[1] * t[4 * j4 + 1]; if (4 * j4 + 2 < i) s2 -= l[2] * t[4 * j4 + 2]; if (4 * j4 + 3 < i) s3 -= l[3] * t[4 * j4 + 3]; }
            t[i] = (s0 + s1) + (s2 + s3); asm volatile("" : "+v"(t[i]) : : "memory"); }
        const float bu = gcv[64 + cl], bw = bu * gcv[128 + cl];
        LAS bf16* Tu = (LAS bf16*)(L0 + GP_REG + w * GP_REGB); LAS bf16* Tw = Tu + 2304;
#pragma unroll
        for (int i = 0; i < 64; ++i) if (cl < 8 * ((i >> 3) + 1)) { Tu[offT(i) + cl] = f2bf(t[i] * bu); Tw[offT(i) + cl] = f2bf(t[i] * bw); }
    }
    __syncthreads();
    { int tgC; asm volatile("v_mov_b32 %0, %1" : "=v"(tgC) : "v"(tg));
      PrepRegs R; prep_load(R, F.ws, bid + 256 * g, tgC, 2, 1);
      for (int up = 0; up < 4; ++up) { const int ui = 2 * up + g, u = bid + 256 * ui;
        int ln; asm volatile("v_mov_b32 %0, %1" : "=v"(ln) : "v"(F.lane));
        const int c = ln & 31, hi = ln >> 5;
        int tgs; asm volatile("v_mov_b32 %0, %1" : "=v"(tgs) : "v"(tg));
        LAS bf16* Vt = T0;
        prep_write(R, Vt, Kt, tgs, F.in[I_CONVW], (u >> 7) & 7, 2, 1);
        if (up + 1 < 4) prep_load(R, F.ws, u + 512, tgs, 2, 1);
        __syncthreads();
        const LAS bf16* Tb = (const LAS bf16*)(L0 + GP_REG + ui * GP_REGB);
#pragma unroll 1
        for (int jj = 0; jj < 4; ++jj) { const int job = 4 * wg + jj, mat = job >> 3, rbi = (job >> 2) & 1, cb = job & 3; const LAS bf16* TA = Tb + mat * 2304; const LAS bf16* X = mat ? Kt : Vt;
            const int i = 32 * rbi + c, G = i >> 3, to = 32 * G * (G + 1) + 8 * (G + 1) * (i - 8 * G);
            f32x16 acc = {};
#pragma unroll
            for (int s = 0; s < 4; ++s) { if (s >= 2 && rbi == 0) continue;
                const int k0 = 16 * s + 8 * hi; bf16x8 a = *(const LAS bf16x8*)(TA + to + (k0 <= i ? k0 : 0)); if (k0 > i) a = (bf16x8){0, 0, 0, 0, 0, 0, 0, 0};
                bf16x8 bb;
#pragma unroll
                for (int e = 0; e < 8; ++e) bb[e] = (short)X[(16 * s + 8 * hi + e) * 136 + 32 * cb + c];
                acc = __builtin_amdgcn_mfma_f32_32x32x16_bf16(a, bb, acc, 0, 0, 0); }
            if (mat) { bf16* o = WSP(bf16, WS_GW) + (size_t)u * 8192 + 32 * cb + c;
#pragma unroll
                for (int r = 0; r < 16; ++r) o[(32 * rbi + crow(r, hi)) * 128] = f2bf(acc[r]); }
            else { bf16* o = WSP(bf16, WS_GU) + (size_t)u * 8192 + (32 * cb + c) * 64 + 32 * rbi + 4 * hi;
#pragma unroll
                for (int gq = 0; gq < 4; ++gq) { u32x2 v; v.x = cvt_pk_bf16(acc[4 * gq], acc[4 * gq + 1]); v.y = cvt_pk_bf16(acc[4 * gq + 2], acc[4 * gq + 3]); *(u32x2*)(o + 8 * gq) = v; } } }
        __syncthreads();
      } }
}
constexpr int SB_W = 0, SB_QD = 16384, SB_KDT = 32768, SB_AT = 49152, SB_SZ = 57344, SB_PW = 2 * SB_SZ, SB_PWB = 6656;
static_assert(SB_PW + 4 * SB_PWB <= RING_BYTES, "scan LDS");
struct ScanRegs { u32x4 w[4], qd[4], kd[4], at[2]; };
__device__ __forceinline__ void scan_load(ScanRegs& R, const unsigned char* ws, size_t u, int lt) {
    const bf16* gw_ = (const bf16*)(ws + WS_GW) + u * 8192; const bf16* gq = (const bf16*)(ws + WS_GQD) + u * 8192; const bf16* gk = (const bf16*)(ws + WS_GKDT) + u * 8192; const bf16* ga = (const bf16*)(ws + WS_GATT) + u * 4096;
#pragma unroll
    for (int i = 0; i < 4; ++i) { const int id = lt + 256 * i; R.w[i] = *(const u32x4*)(gw_ + id * 8); R.qd[i] = *(const u32x4*)(gq + id * 8); R.kd[i] = *(const u32x4*)(gk + id * 8); }
#pragma unroll
    for (int i = 0; i < 2; ++i) { const int id = lt + 256 * i; R.at[i] = *(const u32x4*)(ga + id * 8); }
}
__device__ __forceinline__ void scan_write(const ScanRegs& R, LAS unsigned char* buf, int lt) {
#pragma unroll
    for (int i = 0; i < 4; ++i) { const int id = lt + 256 * i; { const int row = id >> 4, cc = id & 15, o = row * 256 + ((cc ^ (row & 15)) << 4); *(LAS u32x4*)(buf + SB_W + o) = R.w[i]; *(LAS u32x4*)(buf + SB_QD + o) = R.qd[i]; }
        { const int row = id >> 3, cc = id & 7; *(LAS u32x4*)(buf + SB_KDT + row * 128 + ((cc ^ ((row >> 1) & 7)) << 4)) = R.kd[i]; } }
#pragma unroll
    for (int i = 0; i < 2; ++i) { const int id = lt + 256 * i, row = id >> 3, cc = id & 7; *(LAS u32x4*)(buf + SB_AT + row * 128 + ((cc ^ ((row >> 1) & 7)) << 4)) = R.at[i]; }
}
#define SCAN_BAR() do { asm volatile("s_waitcnt lgkmcnt(0)" ::: "memory"); __builtin_amdgcn_s_barrier(); asm volatile("" ::: "memory"); } while (0)
__device__ __forceinline__ void scan_compute(LAS unsigned char* buf, LAS bf16* SbT, LAS bf16* VNT, f32x4 (&S)[8], const u32x2 (&uu)[4], float gl, float* go, int c, int q) {
    int a256[4], a128[2];
#pragma unroll
    for (int ks = 0; ks < 4; ++ks) a256[ks] = c * 256 + (((4 * ks + q) ^ c) << 4);
#pragma unroll
    for (int ks = 0; ks < 2; ++ks) a128[ks] = c * 128 + (((4 * ks + q) ^ ((c >> 1) & 7)) << 4);
#pragma unroll
    for (int rt = 0; rt < 8; ++rt) { u32x2 o; o.x = cvt_pk_bf16(S[rt][0], S[rt][1]); o.y = cvt_pk_bf16(S[rt][2], S[rt][3]); *(LAS u32x2*)(SbT + c * 136 + 16 * rt + 4 * q) = o; }
    bf16x8 sb[4];
#pragma unroll
    for (int ks = 0; ks < 4; ++ks) sb[ks] = *(const LAS bf16x8*)(SbT + c * 136 + 32 * ks + 8 * q);
#pragma unroll
    for (int rt = 0; rt < 4; ++rt) { f32x4 p = {0.f, 0.f, 0.f, 0.f};
#pragma unroll
        for (int ks = 0; ks < 4; ++ks) p = __builtin_amdgcn_mfma_f32_16x16x32_bf16(*(const LAS bf16x8*)(buf + SB_W + rt * 4096 + a256[ks]), sb[ks], p, 0, 0, 0);
        u32x2 o; o.x = cvt_pk_bf16(bf_lo(uu[rt].x) - p[0], bf_hi(uu[rt].x) - p[1]); o.y = cvt_pk_bf16(bf_lo(uu[rt].y) - p[2], bf_hi(uu[rt].y) - p[3]); *(LAS u32x2*)(VNT + c * 72 + 16 * rt + 4 * q) = o; }
    bf16x8 vb[2];
#pragma unroll
    for (int ks = 0; ks < 2; ++ks) vb[ks] = *(const LAS bf16x8*)(VNT + c * 72 + 32 * ks + 8 * q);
#pragma unroll
    for (int rt = 0; rt < 4; ++rt) { f32x4 p = {0.f, 0.f, 0.f, 0.f};
#pragma unroll
        for (int ks = 0; ks < 4; ++ks) p = __builtin_amdgcn_mfma_f32_16x16x32_bf16(*(const LAS bf16x8*)(buf + SB_QD + rt * 4096 + a256[ks]), sb[ks], p, 0, 0, 0);
#pragma unroll
        for (int ks = 0; ks < 2; ++ks) p = __builtin_amdgcn_mfma_f32_16x16x32_bf16(*(const LAS bf16x8*)(buf + SB_AT + rt * 2048 + a128[ks]), vb[ks], p, 0, 0, 0);
#pragma unroll
        for (int e = 0; e < 4; ++e) go[(size_t)(16 * rt + 4 * q + e) * FW] = p[e]; }
#pragma unroll
    for (int rt = 0; rt < 8; ++rt) { f32x4 p = S[rt] * gl;
#pragma unroll
        for (int ks = 0; ks < 2; ++ks) p = __builtin_amdgcn_mfma_f32_16x16x32_bf16(*(const LAS bf16x8*)(buf + SB_KDT + rt * 2048 + a128[ks]), vb[ks], p, 0, 0, 0);
        S[rt] = p; }
}
__device__ __forceinline__ void p4_gdn_scan_item(Frame& F, int item) {
    LAS unsigned char* L0 = F.lds + RING_OFF; LAS unsigned char* buf0 = L0; LAS unsigned char* buf1 = L0 + SB_SZ;
    const int w = F.wave, bh = item >> 1, half = item & 1, h = bh & 7, b = bh >> 3; const size_t u0 = (size_t)bh * NCHUNK;
    int tid_; asm volatile("v_mov_b32 %0, %1" : "=v"(tid_) : "v"(F.tid));
    if (w >= 4) {
        const int lt = tid_ - 256; ScanRegs A, B;
        scan_load(A, F.ws, u0, lt); scan_load(B, F.ws, u0 + 1, lt);
        scan_write(A, buf0, lt); scan_load(A, F.ws, u0 + 2, lt);
        SCAN_BAR();
        for (int n = 0; n < NCHUNK; n += 2) {
            scan_write(B, buf1, lt); scan_load(B, F.ws, u0 + (n + 3 < NCHUNK ? n + 3 : NCHUNK - 1), lt);
            SCAN_BAR();
            scan_write(A, buf0, lt); scan_load(A, F.ws, u0 + (n + 4 < NCHUNK ? n + 4 : NCHUNK - 1), lt);
            SCAN_BAR();
        }
    } else {
        const int c = tid_ & 15, q = (tid_ & 63) >> 4, col = 64 * half + 16 * w + c;
        LAS bf16* SbT = (LAS bf16*)(L0 + SB_PW + w * SB_PWB); LAS bf16* VNT = SbT + 16 * 136;
        f32x4 S[8];
#pragma unroll
        for (int i = 0; i < 8; ++i) S[i] = (f32x4){0.f, 0.f, 0.f, 0.f};
        const bf16* gu = WSP(bf16, WS_GU) + u0 * 8192 + col * 64 + 4 * q; const float* ggl = WSP(float, WS_GGL) + u0;
        float* go = WSP(float, WS_GO) + ((size_t)b * SEQ) * FW + h * HD + col;
        u32x2 ua[4], ub[4]; float gla, glb;
#pragma unroll
        for (int rt = 0; rt < 4; ++rt) ua[rt] = *(const u32x2*)(gu + 16 * rt);
        gla = ggl[0];
        SCAN_BAR();
        for (int n = 0; n < NCHUNK; n += 2) {
            { const size_t un = (size_t)(n + 1) * 8192;
#pragma unroll
              for (int rt = 0; rt < 4; ++rt) ub[rt] = *(const u32x2*)(gu + un + 16 * rt);
              glb = ggl[n + 1]; }
            scan_compute(buf0, SbT, VNT, S, ua, gla, go + (size_t)n * GCH * FW, c, q);
            SCAN_BAR();
            { const int n2 = n + 2 < NCHUNK ? n + 2 : NCHUNK - 1; const size_t un = (size_t)n2 * 8192;
#pragma unroll
              for (int rt = 0; rt < 4; ++rt) ua[rt] = *(const u32x2*)(gu + un + 16 * rt);
              gla = ggl[n2]; }
            scan_compute(buf1, SbT, VNT, S, ub, glb, go + (size_t)(n + 1) * GCH * FW, c, q);
            SCAN_BAR();
        }
    }
}
struct P5Buf { f32x4 a[2], b[2]; u32x4 z[2]; };
__device__ __forceinline__ void p5_load(P5Buf& B, const Frame& F, int m) {
#pragma unroll
    for (int j = 0; j < 2; ++j) { const int col = 8 * F.lane + 512 * j; const float* op = WSP(float, WS_GO) + (size_t)m * FW + col;
        B.a[j] = *(const f32x4*)op; B.b[j] = *(const f32x4*)(op + 4); B.z[j] = *(const u32x4*)(WSP(bf16, WS_PROJ) + (size_t)m * NPROJ + PC_GZ + col); }
}
__device__ __forceinline__ void p5_row(const P5Buf& B, const Frame& F, int m) {
    const float* nw = F.in[I_ONW];
#pragma unroll
    for (int j = 0; j < 2; ++j) { const int col = 8 * F.lane + 512 * j; f32x4 a = B.a[j], b = B.b[j], z0, z1; pg8::unpack8(B.z[j], z0, z1);
        float ss = (a[0] * a[0] + a[1] * a[1]) + (a[2] * a[2] + a[3] * a[3]) + (b[0] * b[0] + b[1] * b[1]) + (b[2] * b[2] + b[3] * b[3]);
        ss = sum16_dpp(ss);
        const float rs = rsqrtf(ss * (1.f / HD) + RMS_EPS); const f32x4 w0 = *(const f32x4*)(nw + (col & 127)), w1 = *(const f32x4*)(nw + (col & 127) + 4);
#pragma unroll
        for (int e = 0; e < 4; ++e) { a[e] = a[e] * rs * w0[e] * siluf_(z0[e]); b[e] = b[e] * rs * w1[e] * siluf_(z1[e]); }
        *(u32x4*)(WSP(bf16, WS_YF) + (size_t)m * DM + FW + col) = pg8::pack8(a, b); }
}
__device__ __forceinline__ void p5_gdn_outnorm(Frame& F) {
    const int gw = blockIdx.x * NWAVES + F.wave, NGW = F.G * NWAVES;
    P5Buf A, B; if (gw < T) p5_load(A, F, gw);
#pragma unroll 1
    for (int m = gw; m < T; m += 2 * NGW) { if (m + NGW < T) p5_load(B, F, m + NGW); p5_row(A, F, m); if (m + 2 * NGW < T) p5_load(A, F, m + 2 * NGW); if (m + NGW < T) p5_row(B, F, m + NGW); }
}
#endif
#if HAVE_MOE
struct PostRouter { const float* br; unsigned* cnt; int* toke; float* tokw; int* tokp; int lane, wave;
    __device__ __forceinline__ void operator()(int row0, const LAS float* fin) const {
        if (wave != 0) return;
        const int t = row0 + lane; float v[32];
#pragma unroll
        for (int e = 0; e < 32; ++e) v[e] = fin[lane * 33 + e] + br[e];
        int be[4]; float bv[4];
#pragma unroll
        for (int k = 0; k < 4; ++k) { float best = v[0]; int bi = 0;
#pragma unroll
            for (int e = 1; e < 32; ++e) if (v[e] > best) { best = v[e]; bi = e; }
            be[k] = bi; bv[k] = best;
#pragma unroll
            for (int e = 0; e < 32; ++e) v[e] = (e == bi) ? -__builtin_inff() : v[e]; }
        const float e1 = __expf(bv[1] - bv[0]), e2 = __expf(bv[2] - bv[0]), e3 = __expf(bv[3] - bv[0]), inv = 1.f / (1.f + e1 + e2 + e3);
        const float ww[4] = {inv, e1 * inv, e2 * inv, e3 * inv};
#pragma unroll
        for (int k = 0; k < 4; ++k) { const unsigned pos = __hip_atomic_fetch_add(cnt + 64 * be[k], 1u, __ATOMIC_RELAXED, __HIP_MEMORY_SCOPE_AGENT);
            toke[(size_t)t * 4 + k] = be[k]; tokw[(size_t)t * 4 + k] = ww[k]; tokp[(size_t)t * 4 + k] = (int)pos; }
    }
};
__device__ __forceinline__ void p8_router(Frame& F) {
    { const float* x = F.in[I_X]; const bf16* dl = WSP(bf16, WS_TMP); const f32x4* nw = (const f32x4*)F.in[I_N2W] + F.lane; bf16* xn = WSP(bf16, WS_XN2);
      for (int tile = blockIdx.x; tile < T / 64; tile += F.G)
          for (int rr = 0; rr < 8; ++rr) { const int m = tile * 64 + rr * 8 + F.wave;
              const f32x4* xr = (const f32x4*)(x + (size_t)m * DM) + F.lane; const u32x2* dr = (const u32x2*)(dl + (size_t)m * DM) + F.lane; f32x4 v[8]; float ss = 0.f;
#pragma unroll
              for (int j = 0; j < 8; ++j) { const u32x2 d = dr[64 * j]; v[j] = xr[64 * j] + (f32x4){bf_lo(d.x), bf_hi(d.x), bf_lo(d.y), bf_hi(d.y)};
                  ss += (v[j][0] * v[j][0] + v[j][1] * v[j][1]) + (v[j][2] * v[j][2] + v[j][3] * v[j][3]);
#if X1_BF16
                  { u32x2 o; o.x = cvt_pk_bf16(v[j][0], v[j][1]); o.y = cvt_pk_bf16(v[j][2], v[j][3]); ((u32x2*)(WSP(bf16, WS_TMP) + (size_t)m * DM) + F.lane)[64 * j] = o; }
#endif
                  }
              const float rs = rsqrtf(wave_sum(ss) * (1.f / DM) + RMS_EPS);
              u32x2* o8 = (u32x2*)(xn + (size_t)m * DM) + F.lane;
#pragma unroll
              for (int j = 0; j < 8; ++j) { const f32x4 w = nw[64 * j]; u32x2 o; o.x = cvt_pk_bf16(v[j][0] * rs * w[0], v[j][1] * rs * w[1]); o.y = cvt_pk_bf16(v[j][2] * rs * w[2], v[j][3] * rs * w[3]); o8[64 * j] = o;
#if MOE_GATHER
                  ((unsigned*)(WSP(unsigned char, WS_XN8) + (size_t)m * DM) + F.lane)[64 * j] = pg8::pk4_fp8(bf_lo(o.x), bf_hi(o.x), bf_lo(o.y), bf_hi(o.y));
#endif
              }
          } }
    __threadfence_block(); VM_WAIT(); __syncthreads();
    PostRouter P{F.in[I_BR], (unsigned*)(F.ctl + CW_CNT), WSP(int, WS_TOKE), WSP(float, WS_TOKW), WSP(int, WS_TOKP), F.lane, F.wave}; skinny32(F, WSP(bf16, WS_XN2), WSP(bf16, WS_WRT), P);
}
__device__ __forceinline__ int moe_tables(Frame& F, LAS int* base, LAS int* tile_e) {
    LAS int* ntot = base + 32;
    if (F.wave == 0) { const int e = F.lane & 31; const int cnt = (int)__hip_atomic_load((unsigned*)(F.ctl + CW_CNT + 64 * e), __ATOMIC_RELAXED, __HIP_MEMORY_SCOPE_AGENT); const int nt = (cnt + 255) >> 8;
        int incl = nt;
#pragma unroll
        for (int o = 1; o < 32; o <<= 1) { const int t = __shfl_up(incl, o); if ((F.lane & 31) >= o) incl += t; }
        const int off = incl - nt;
        if (F.lane < 32) { base[e] = off * 256; for (int i = 0; i < nt; ++i) tile_e[off + i] = e; if (e == 31) ntot[0] = incl; } }
    LDS_WAIT(); __syncthreads();
    return __builtin_amdgcn_readfirstlane(ntot[0]);
}
__device__ __forceinline__ void p9_gather(Frame& F) {
    LAS int* base = (LAS int*)(F.lds + TAB_OFF); LAS int* tile_e = base + 64;
    (void)moe_tables(F, base, tile_e);
#if MOE_GATHER
    { unsigned short* tos = WSP(unsigned short, WS_TOS);
      for (int a = (int)blockIdx.x * (NWAVES * 64) + F.tid; a < T * TOPK; a += F.G * NWAVES * 64) { const int e = WSP(int, WS_TOKE)[a], slot = base[e] + WSP(int, WS_TOKP)[a]; tos[slot] = (unsigned short)(a >> 2); WSP(int, WS_TOKP)[a] = slot; }
      for (int e = (int)blockIdx.x; e < NE; e += F.G) { const int cnt = (int)__hip_atomic_load((unsigned*)(F.ctl + CW_CNT + 64 * e), __ATOMIC_RELAXED, __HIP_MEMORY_SCOPE_AGENT), end = base[e] + (((cnt + 255) >> 8) << 8);
          for (int s = base[e] + cnt + F.tid; s < end; s += NWAVES * 64) tos[s] = 0; }
      return; }
#endif
    const int gw = blockIdx.x * NWAVES + F.wave, NGW = F.G * NWAVES;
    for (int m = gw; m < T; m += NGW) {
        const u32x4* src = (const u32x4*)(WSP(bf16, WS_XN2) + (size_t)m * DM) + F.lane; u32x4 v[4];
#pragma unroll
        for (int j = 0; j < 4; ++j) v[j] = src[64 * j];
#if MOE_F8_GU
        u32x2 v8[4];
#pragma unroll
        for (int j = 0; j < 4; ++j) { f32x4 a, b; pg8::unpack8(v[j], a, b); v8[j].x = pg8::pk4_fp8(a[0], a[1], a[2], a[3]); v8[j].y = pg8::pk4_fp8(b[0], b[1], b[2], b[3]); }
#endif
#pragma unroll
        for (int k = 0; k < 4; ++k) { const int e = WSP(int, WS_TOKE)[(size_t)m * 4 + k], pos = WSP(int, WS_TOKP)[(size_t)m * 4 + k], slot = base[e] + pos;
#if MOE_F8_GU
            u32x2* d = (u32x2*)(WSP(unsigned char, WS_XS) + (size_t)slot * DM) + F.lane;
#pragma unroll
            for (int j = 0; j < 4; ++j) d[64 * j] = v8[j];
#else
            u32x4* d = (u32x4*)(WSP(bf16, WS_XS) + (size_t)slot * DM) + F.lane;
#pragma unroll
            for (int j = 0; j < 4; ++j) d[64 * j] = v[j];
#endif
            if (F.lane == 0) WSP(int, WS_TOKP)[(size_t)m * 4 + k] = slot; }
    }
}
__device__ __forceinline__ void p10_gateup(Frame& F) {
    LAS int* base = (LAS int*)(F.lds + TAB_OFF); LAS int* tile_e = base + 64;
    const int NT = moe_tables(F, base, tile_e);
    pg8::MoeOrder S; S.init(NT, 16, F.G, (int)blockIdx.x); S.tile_e = tile_e; S.nrows_e = 4096;
    pg8::EpiSwiglu<MOE_F8_DN != 0> E{WSP(void, WS_ACT), DFF, WSP(float, WS_BGU), MOE_F8_GU ? pg8::W8_INV : 1.f};
#if MOE_GATHER
    LAS unsigned short* TL = (LAS unsigned short*)(F.lds + TLD_OFF);
    { pg8::Unit u; for (int ui = 0; S.next(ui, u); ++ui) if (F.tid < 256) TL[ui * 256 + F.tid] = WSP(unsigned short, WS_TOS)[u.pm * 256 + F.tid]; }
    LDS_WAIT(); __syncthreads();
    pg8::Gemm g{WSP(bf16, WS_XN8), WSP(bf16, WS_WGUT), DM / 2, TL};
    pg8::gemm_phase<pg8::EpiSwiglu<MOE_F8_DN != 0>, pg8::MoeOrder, true, true, true, pg8::NoMid, true>(F.lds + RING_OFF, g, S, E);
#else
    pg8::Gemm g{WSP(bf16, WS_XS), WSP(bf16, WS_WGUT), MOE_F8_GU ? DM / 2 : DM};
    pg8::gemm_phase<pg8::EpiSwiglu<MOE_F8_DN != 0>, pg8::MoeOrder, true, true, MOE_F8_GU != 0>(F.lds + RING_OFF, g, S, E);
#endif
}
__device__ __forceinline__ void p11_down(Frame& F) {
    LAS int* base = (LAS int*)(F.lds + TAB_OFF); LAS int* tile_e = base + 64;
    const int NT = moe_tables(F, base, tile_e);
    pg8::MoeOrder S; S.init(NT, 8, F.G, (int)blockIdx.x); S.tile_e = tile_e; S.nrows_e = DM;
#if YB_F8
    pg8::EpiF8 E{WSP(unsigned char, WS_YB), DM, F.in[I_BD], DM, MOE_F8_DN ? pg8::W8_INV : 1.f};
    pg8::Gemm g{WSP(bf16, WS_ACT), WSP(bf16, WS_WDT), MOE_F8_DN ? DFF / 2 : DFF};
    pg8::gemm_phase<pg8::EpiF8, pg8::MoeOrder, true, true, MOE_F8_DN != 0>(F.lds + RING_OFF, g, S, E);
#else
    pg8::EpiBf16 E{WSP(bf16, WS_YB), DM, F.in[I_BD], DM, MOE_F8_DN ? pg8::W8_INV : 1.f};
    pg8::Gemm g{WSP(bf16, WS_ACT), WSP(bf16, WS_WDT), MOE_F8_DN ? DFF / 2 : DFF};
    pg8::gemm_phase<pg8::EpiBf16, pg8::MoeOrder, true, true, MOE_F8_DN != 0>(F.lds + RING_OFF, g, S, E);
#endif
}
struct P12Buf { f32x4 xa[4], xb[4]; u32x4 d[4]; u32x2 y[4][4]; };
__device__ __forceinline__ void p12_load(P12Buf& B, const Frame& F, int m, const int (&sl)[4]) {
    const float* xrow = F.in[I_X] + (size_t)m * DM + 8 * F.lane; const bf16* drow = WSP(bf16, WS_TMP) + (size_t)m * DM + 8 * F.lane;
#pragma unroll
    for (int j = 0; j < 4; ++j) { B.xa[j] = *(const f32x4*)(xrow + 512 * j); B.xb[j] = *(const f32x4*)(xrow + 512 * j + 4); B.d[j] = *(const u32x4*)(drow + 512 * j);
#pragma unroll
        for (int k = 0; k < 4; ++k) B.y[j][k] = *(const u32x2*)(WSP(unsigned char, WS_YB) + (size_t)sl[k] * DM + 8 * F.lane + 512 * j); }
}
__device__ __forceinline__ void p12_store(const P12Buf& B, const Frame& F, int m, const float (&ww)[4]) {
    float* orow = F.out + (size_t)m * DM + 8 * F.lane;
#pragma unroll
    for (int j = 0; j < 4; ++j) { f32x4 a = B.xa[j], b = B.xb[j], d0, d1; pg8::unpack8(B.d[j], d0, d1); a += d0; b += d1;
#pragma unroll
        for (int k = 0; k < 4; ++k) { const u32x2 yw = B.y[j][k];
            const f32x2 p0 = __builtin_amdgcn_cvt_pk_f32_fp8((int)yw.x, false), p1 = __builtin_amdgcn_cvt_pk_f32_fp8((int)yw.x, true), p2 = __builtin_amdgcn_cvt_pk_f32_fp8((int)yw.y, false), p3 = __builtin_amdgcn_cvt_pk_f32_fp8((int)yw.y, true);
            a += (f32x4){p0[0], p0[1], p1[0], p1[1]} * ww[k]; b += (f32x4){p2[0], p2[1], p3[0], p3[1]} * ww[k]; }
        *(f32x4*)(orow + 512 * j) = a; *(f32x4*)(orow + 512 * j + 4) = b; }
}
__device__ __forceinline__ void p12_combine(Frame& F) {
    static_assert(YB_F8 != 0, "the combine phase reads fp8 YB rows");
    const int gw = blockIdx.x * NWAVES + F.wave, NGW = F.G * NWAVES;
    for (int m0 = gw; m0 < T; m0 += 8 * NGW) {
        int slv = 0; float wwv = 0.f;
        { const int i = F.lane >> 2, m = m0 + i * NGW; if (F.lane < 32 && m < T) { slv = WSP(int, WS_TOKP)[(size_t)m * 4 + (F.lane & 3)]; wwv = WSP(float, WS_TOKW)[(size_t)m * 4 + (F.lane & 3)]; } }
        P12Buf A, B; int sl[4]; float wa[4], wb[4];
#define P12_META(i, w) do { _Pragma("unroll") for (int k = 0; k < 4; ++k) { sl[k] = __builtin_amdgcn_readlane(slv, 4 * (i) + k); w[k] = __builtin_bit_cast(float, __builtin_amdgcn_readlane(__builtin_bit_cast(int, wwv), 4 * (i) + k)); } } while (0)
        P12_META(0, wa); p12_load(A, F, m0, sl);
#pragma unroll 1
        for (int i = 0; i < 8; i += 2) {
            const int ma = m0 + i * NGW, mb = ma + NGW, mc = mb + NGW;
            if (mb < T) { P12_META(i + 1, wb); p12_load(B, F, mb, sl); }
            p12_store(A, F, ma, wa);
            if (mb >= T) break;
            if (i + 2 < 8 && mc < T) { P12_META(i + 2, wa); p12_load(A, F, mc, sl); }
            p12_store(B, F, mb, wb);
            if (mc >= T) break;
        }
#undef P12_META
    }
}
#endif
struct Args { const float* in[20]; float* out; unsigned char* ws; int ph_lo, ph_hi, li, pad; };
__global__ void __launch_bounds__(NWAVES * 64, 2) fwd_kernel(Args args) {
    extern __shared__ __attribute__((aligned(16))) unsigned char lds[];
    Frame F;
    F.lds = (LAS unsigned char*)lds;
    F.MISC = (volatile LAS unsigned*)(F.lds + MISC_OFF);
    F.tid = threadIdx.x; F.lane = F.tid & 63; F.wave = __builtin_amdgcn_readfirstlane(F.tid >> 6);
    F.G = gridDim.x; F.ws = args.ws; F.ctl = (gu32*)(args.ws + WS_CTL); F.out = args.out;
#pragma unroll
    for (int i = 0; i < 20; ++i) F.in[i] = args.in[i];
    for (int u = F.tid; u < (LDS_BYTES - LDSCTL_OFF) / 4; u += NWAVES * 64) ((LAS unsigned*)(F.lds + LDSCTL_OFF))[u] = 0u;
    __syncthreads();
    const int lo = args.ph_lo, hi = args.ph_hi;
    XcdBarrier bar; bar.bar = (unsigned*)(F.ctl + CW_BAR) + (args.li % 3) * XCD_BAR_WORDS; bar.x = 0; bar.st = nullptr;
    if (hi - lo > 1) bar = xcd_barrier_post((unsigned*)(F.ctl + CW_BAR) + (args.li % 3) * XCD_BAR_WORDS, F.MISC + 8);
#define IN(k) (lo <= (k) && (k) < hi)
#define SEAM(k) do { if (IN(k) && IN((k) + 1)) xcd_barrier(bar); } while (0)
    using namespace pg8;
    PG8_LAS unsigned char* ring = F.lds + RING_OFF;

    if (IN(0)) { p0_prologue(F); }
    SEAM(0);
    if (IN(1)) {
        { PostSmall P{WSP(float, WS_SMALLP), F.tid, F.in[I_BFF], (float*)(F.ctl + CW_TS)}; skinny32(F, WSP(bf16, WS_H1), WSP(bf16, WS_WST), P); }
#if GATES_F8
        { Gemm g{WSP(bf16, WS_H1), WSP(bf16, WS_WINT), DM}; DenseOrder S; S.init(T / 256, 7168 / 256, F.G, (int)blockIdx.x);
          EpiProj E{WSP(bf16, WS_PROJ), WSP(bf16, WS_QN), WSP(bf16, WS_KN), F.in[I_QNW], F.in[I_KNW], (PG8_LAS float*)(ring + 3 * HTB), WSP(bf16, WS_VN)};
          gemm_phase<EpiProj, DenseOrder, true, true>(ring, g, S, E); }
        { Gemm g{WSP(bf16, WS_H8), WSP(bf16, WS_WIN8), DM / 2}; DenseOrder S; S.init(T / 256, 4096 / 256, F.G, (int)blockIdx.x);
#if GATES_SIG == 3
          EpiSigRS E{WSP(bf16, WS_PROJ) + PC_GA, WSP(bf16, WS_PROJ) + PC_GB, W8_INV};
          gemm_phase<EpiSigRS, DenseOrder, true, true, true>(ring, g, S, E); }
#elif GATES_SIG
          EpiSig E{WSP(bf16, WS_PROJ) + PC_GA, NPROJ, W8_INV};
          gemm_phase<EpiSig, DenseOrder, true, true, true>(ring, g, S, E); }
#else
          EpiBf16 E{WSP(bf16, WS_PROJ) + PC_GA, NPROJ, nullptr, 0, W8_INV};
          gemm_phase<EpiBf16, DenseOrder, true, true, true>(ring, g, S, E); }
#endif
#else
        { Gemm g{WSP(bf16, WS_H1), WSP(bf16, WS_WINT), DM}; DenseOrder S; S.init(T / 256, NPROJ / 256, F.G, (int)blockIdx.x);
          EpiBf16 E{WSP(bf16, WS_PROJ), NPROJ, nullptr, 0, 1.f};
          gemm_phase<EpiBf16, DenseOrder, true, true>(ring, g, S, E); }
#endif
    }
    SEAM(1);
    if (IN(2)) {
        p2_cb_tile(F, (int)blockIdx.x);
        p3_gdn_prep(F, (int)blockIdx.x);
    }
    SEAM(2);
    if (IN(4)) {
        const int qw = CW_Q + 2048 * args.li;
#if CONV_IN_P4
        const bool conv_first = (int)blockIdx.x < CONV_WGS_P4;
        if (conv_first) p4_conversion(F);
#endif
#if HAVE_GDN
        for (;;) { const int it = dequeue(F, qw, 4); if (it < 0) break; p4_gdn_scan_item(F, it); }
#endif
        p4_attention(F, (char*)lds + RING_OFF, qw + 512);
#if CONV_IN_P4
        p4_conversion(F);
#endif
    }
    SEAM(4);
#if HAVE_GDN
    if (IN(5)) { p5_gdn_outnorm(F); }
#endif
    SEAM(5);
    if (IN(6)) {
        DenseOrder S; S.init(T / 256, DM / 256, F.G, (int)blockIdx.x);
        Gemm g{WSP(bf16, WS_YF), WSP(bf16, WS_WUFT), DM};
#if GATES_SIG == 3
        MidGateR M{WSP(bf16, WS_PROJ) + PC_GA, NPROJ};
        EpiGateOutS E{WSP(bf16, WS_PROJ) + PC_GB, NPROJ, WSP(bf16, WS_MERGED), DM};
        gemm_phase<EpiGateOutS, DenseOrder, true, true, false, MidGateR>(ring, g, S, E, M);
#elif GATES_SIG == 1
        MidGateS M{WSP(bf16, WS_PROJ) + PC_GA, WSP(bf16, WS_PROJ) + PC_GB, NPROJ};
        EpiGateOutS E{WSP(bf16, WS_PROJ) + PC_GB, NPROJ, WSP(bf16, WS_MERGED), DM};
        gemm_phase<EpiGateOutS, DenseOrder, true, true, false, MidGateS>(ring, g, S, E, M);
#else
        MidGate M{WSP(bf16, WS_PROJ) + PC_GA, WSP(bf16, WS_PROJ) + PC_GB, NPROJ};
        EpiGateOut E{WSP(bf16, WS_PROJ) + PC_GB, NPROJ, WSP(bf16, WS_MERGED), DM};
        gemm_phase<EpiGateOut, DenseOrder, true, true, false, MidGate>(ring, g, S, E, M);
#endif
    }
    SEAM(6);
    if (IN(7)) {
        Gemm g{WSP(bf16, WS_MERGED), WSP(bf16, WS_WOT), DM}; DenseOrder S; S.init(T / 256, DM / 256, F.G, (int)blockIdx.x);
        EpiBf16 E{WSP(bf16, WS_TMP), DM, nullptr, 0, 1.f};
        gemm_phase<EpiBf16, DenseOrder, true, true>(ring, g, S, E);
    }
    SEAM(7);
#if HAVE_MOE
    if (IN(8)) { p8_router(F); }
    SEAM(8);
    if (IN(9)) { p9_gather(F); }
    SEAM(9);
    if (IN(10)) { p10_gateup(F); }
    SEAM(10);
    if (IN(11)) { p11_down(F); }
    SEAM(11);
    if (IN(12)) { p12_combine(F); }
#endif
#undef IN
#undef SEAM
}

extern "C" void kernel_launch(void* const* d_in, const int* in_sizes, int n_in, void* d_out, int out_size, void* d_ws, size_t ws_size, hipStream_t stream) {
    static int grid = 0;
    if (grid == 0) {
        if (n_in != 20 || in_sizes[0] != T * DM || out_size != T * DM || ws_size < WS_END) { fprintf(stderr, "kernel_launch: unexpected shapes (n_in %d, in0 %d, out %d, ws %zu < %zu); nothing launched\n", n_in, n_in > 0 ? in_sizes[0] : -1, out_size, ws_size, (size_t)WS_END); grid = -1; return; }
        int dev = 0, cus = 0, per_cu = 0;
        if (hipGetDevice(&dev) != hipSuccess || hipDeviceGetAttribute(&cus, hipDeviceAttributeMultiprocessorCount, dev) != hipSuccess) { grid = -1; return; }
        if (hipFuncSetAttribute((const void*)fwd_kernel, hipFuncAttributeMaxDynamicSharedMemorySize, LDS_BYTES) != hipSuccess) { fprintf(stderr, "kernel_launch: hipFuncSetAttribute failed\n"); grid = -1; return; }
        if (hipOccupancyMaxActiveBlocksPerMultiprocessor(&per_cu, (const void*)fwd_kernel, NWAVES * 64, LDS_BYTES) != hipSuccess || per_cu < 1) fprintf(stderr, "kernel_launch: note: occupancy query reports %d workgroups per CU\n", per_cu);
        (void)hipGetLastError();
        grid = cus;
        if (grid != 256) fprintf(stderr, "kernel_launch: %d CUs; this kernel is laid out for 256\n", grid);
    }
    if (grid < 0) return;
    if (hipMemsetAsync((char*)d_ws + WS_CTL, 0, CTL_ZERO_BYTES, stream) != hipSuccess) return;
    Args a{};
    for (int i = 0; i < 20; ++i) a.in[i] = (const float*)d_in[i];
    a.out = (float*)d_out; a.ws = (unsigned char*)d_ws;
    static const int ranges[] = {MK_RANGES};
    for (int li = 0; 2 * li + 1 < (int)(sizeof(ranges) / sizeof(ranges[0])); ++li) { a.ph_lo = ranges[2 * li]; a.ph_hi = ranges[2 * li + 1]; a.li = li; hipLaunchKernelGGL(fwd_kernel, dim3(grid), dim3(NWAVES * 64), LDS_BYTES, stream, a); }
}
```
